# Optimizing an MI355X kernel written in HIP

```python
import math
import jax, jax.numpy as jnp
from jax import lax
import numpy as np

D_MODEL = 1024
BATCH = 8
SEQ = 4096
DEPTH = 4

HEAD_DIM = 64
RWKV_HEADS = 4
ATTN_HEADS = 8
RET_HEADS = 4
RWKV_DIM = RWKV_HEADS * HEAD_DIM
ATTN_DIM = ATTN_HEADS * HEAD_DIM
RET_DIM = RET_HEADS * HEAD_DIM
D_MIX = RWKV_DIM + ATTN_DIM + RET_DIM
DECAY_LORA = 64
ICL_LORA = 64
GATE_LORA = 128
RWKV_SPLITS = (RWKV_DIM, 2 * RWKV_DIM, 3 * RWKV_DIM, 3 * RWKV_DIM + DECAY_LORA, 3 * RWKV_DIM + DECAY_LORA + ICL_LORA)
RWKV_IN = 3 * RWKV_DIM + DECAY_LORA + ICL_LORA + GATE_LORA
ATTN_IN = 3 * ATTN_DIM
RET_IN = 4 * RET_DIM
N_IN = RWKV_IN + ATTN_IN + RET_IN
RWKV_GN_EPS = 64e-5
DECAY_SCALE = math.exp(-0.5)
DILATED_PATTERNS = ((128, 1), (512, 4), (2048, 16))
NUM_BUCKETS = 32
MAX_DISTANCE = 2048
ROPE_BASE = 10000.0
RET_CHUNK = 128
FF_DENSE = 2816
N_EXPERTS = 8
TOP_K = 2
FF_EXPERT = 3584
MOE_BLOCK = 256
LN_EPS = 1e-5
DEEPNORM_ALPHA = (2 * DEPTH) ** 0.25
DEEPNORM_BETA = (8 * DEPTH) ** -0.25
N_DENSE = (DEPTH + 1) // 2
N_MOE = DEPTH // 2

kernel_name = 'hybrid_rwkv7_dilated_retention_moe_deepnorm'


def layer_norm(x, g, b):
    xf = x.astype(jnp.float32)
    mu = xf.mean(-1, keepdims=True)
    var = jnp.square(xf - mu).mean(-1, keepdims=True)
    return ((xf - mu) * lax.rsqrt(var + LN_EPS) * g + b).astype(x.dtype)


def head_group_norm(y, g, b, eps):
    b_, s_, h, n = y.shape
    yf = y.astype(jnp.float32)
    mu = yf.mean(-1, keepdims=True)
    var = jnp.square(yf - mu).mean(-1, keepdims=True)
    return ((yf - mu) * lax.rsqrt(var + eps)).reshape(b_, s_, h * n) * g + b


def token_shift(p):
    return jnp.pad(p, ((0, 0), (1, 0), (0, 0)))[:, :-1]


def swiglu(x, wg, wu, wd):
    return (jax.nn.silu(x @ wg) * (x @ wu)) @ wd


def wkv7_scan(r, w, k, v, kap, a):
    def step(state, inp):
        r_t, w_t, k_t, v_t, kap_t, a_t = inp
        sa = jnp.einsum('bhvk,bhk->bhv', state, -kap_t)
        state = (state * w_t[:, :, None, :]
                 + jnp.einsum('bhv,bhk->bhvk', sa, kap_t * a_t)
                 + jnp.einsum('bhv,bhk->bhvk', v_t, k_t))
        return state, jnp.einsum('bhvk,bhk->bhv', state, r_t)
    b_, s_, h, n = r.shape
    s0 = jnp.zeros((b_, h, n, n), jnp.float32)
    xs = tuple(jnp.moveaxis(t, 1, 0) for t in (r, w, k, v, kap, a))
    _, ys = lax.scan(step, s0, xs)
    return jnp.moveaxis(ys, 0, 1)


def rwkv7_time_mix(p, mu, w0, w_up, a0, a_up, g_up, k_k, k_a, r_k, ln_g, ln_b):
    b_, s_, _ = p.shape
    p = p + (token_shift(p) - p) * mu
    r, k, v, xw, xa, xg = jnp.split(p, RWKV_SPLITS, axis=-1)
    decay = jnp.exp(-DECAY_SCALE * jax.nn.sigmoid((w0 + jnp.tanh(xw) @ w_up).astype(jnp.float32)))
    a = jax.nn.sigmoid((a0 + xa @ a_up).astype(jnp.float32))
    g = (jax.nn.sigmoid(xg) @ g_up).astype(jnp.float32)
    heads = lambda t: t.astype(jnp.float32).reshape(b_, s_, RWKV_HEADS, HEAD_DIM)
    hv = lambda t: t.astype(jnp.float32).reshape(RWKV_HEADS, HEAD_DIM)
    r, k, v, a, decay = heads(r), heads(k), heads(v), heads(a), heads(decay)
    kap = k * hv(k_k)
    kap = kap / jnp.maximum(jnp.sqrt(jnp.sum(kap * kap, -1, keepdims=True)), 1e-12)
    k = k * (1.0 + (a - 1.0) * hv(k_a))
    y = wkv7_scan(r, decay, k, v, kap, a)
    y = head_group_norm(y, ln_g, ln_b, RWKV_GN_EPS)
    bonus = (jnp.sum(r * k * hv(r_k), -1, keepdims=True) * v).reshape(b_, s_, RWKV_DIM)
    return (y + bonus) * g


def t5_bucket(dist):
    max_exact = NUM_BUCKETS // 2
    large = max_exact + (np.log(np.maximum(dist, max_exact) / max_exact)
                         / math.log(MAX_DISTANCE / max_exact) * (NUM_BUCKETS - max_exact)).astype(np.int32)
    return np.where(dist < max_exact, dist, np.minimum(large, NUM_BUCKETS - 1)).astype(np.int32)


def dilated_window_attention(q, k, v, rel_bias, window, dilation):
    b_, s_, h, dh = q.shape
    w = window // dilation
    l = s_ // dilation
    nb = -(-l // w)
    lp = nb * w

    def blocks(t):
        t = t.reshape(b_, l, dilation, h, dh)
        t = jnp.pad(t, ((0, 0), (0, lp - l), (0, 0), (0, 0), (0, 0)))
        return t.reshape(b_, nb, w, dilation, h, dh)

    qb, kb, vb = blocks(q), blocks(k), blocks(v)
    prev = lambda t: jnp.concatenate([jnp.zeros_like(t[:, :1]), t[:, :-1]], axis=1)
    kk = jnp.concatenate([prev(kb), kb], axis=2)
    vv = jnp.concatenate([prev(vb), vb], axis=2)
    i = np.arange(w)[:, None]
    j = np.arange(2 * w)[None, :]
    rel = i + w - j
    band = (rel >= 0) & (rel <= w)
    first = (np.arange(nb) == 0)[:, None, None]
    valid = band[None] & ~(first & (j < w)[None])
    bucket = t5_bucket(np.clip(rel, 0, None) * dilation)
    bias = jnp.transpose(rel_bias[bucket], (2, 0, 1)).astype(jnp.float32)
    s = jnp.einsum('bnidhe,bnjdhe->bndhij', qb, kk).astype(jnp.float32) * (dh ** -0.5) + bias
    s = jnp.where(valid[None, :, None, None], s, -jnp.inf)
    m = s.max(-1, keepdims=True)
    pr = jnp.exp(s - m)
    den = pr.sum(-1)
    o = jnp.einsum('bndhij,bnjdhe->bndhie', pr, vv.astype(jnp.float32)) / den[..., None]
    lse = m[..., 0] + jnp.log(den)
    o = jnp.transpose(o, (0, 1, 4, 2, 3, 5)).reshape(b_, lp, dilation, h, dh)[:, :l].reshape(b_, s_, h, dh)
    lse = jnp.transpose(lse, (0, 1, 4, 2, 3)).reshape(b_, lp, dilation, h)[:, :l].reshape(b_, s_, h)
    return o, lse


def dilated_attention_mixture(p, rel_bias):
    b_, s_, _ = p.shape
    q, k, v = (t.reshape(b_, s_, ATTN_HEADS, HEAD_DIM) for t in jnp.split(p, 3, axis=-1))
    outs, lses = [], []
    for window, dilation in DILATED_PATTERNS:
        o, lse = dilated_window_attention(q, k, v, rel_bias, window, dilation)
        outs.append(o)
        lses.append(lse)
    wts = jax.nn.softmax(jnp.stack(lses), axis=0)
    out = jnp.einsum('pbsh,pbshe->bshe', wts, jnp.stack(outs))
    return out.reshape(b_, s_, ATTN_DIM)


def rotary(x):
    s_, dh = x.shape[1], x.shape[-1]
    half = dh // 2
    inv = ROPE_BASE ** (-jnp.arange(half, dtype=jnp.float32) / half)
    ang = jnp.arange(s_, dtype=jnp.float32)[:, None] * inv
    cos, sin = jnp.cos(ang)[None, :, None, :], jnp.sin(ang)[None, :, None, :]
    x1, x2 = x[..., :half], x[..., half:]
    return jnp.concatenate([x1 * cos - x2 * sin, x1 * sin + x2 * cos], axis=-1)


def retention_chunkwise(q, k, v):
    b_, s_, h, dk = q.shape
    c = RET_CHUNK
    nc = s_ // c
    log_g = jnp.log1p(-jnp.exp2(-5.0 - jnp.arange(h, dtype=jnp.float32)))
    n = jnp.arange(c, dtype=jnp.float32)
    diff = n[:, None] - n[None, :]
    d_intra = jnp.where(diff >= 0, jnp.exp(log_g[:, None, None] * jnp.maximum(diff, 0.0)), 0.0)
    zeta = jnp.exp(log_g[:, None] * (c - 1 - n))
    xi = jnp.exp(log_g[:, None] * (n + 1))
    chunk_decay = jnp.exp(log_g * c)
    qc, kc, vc = (t.reshape(b_, nc, c, h, -1) for t in (q, k, v))
    sc = jnp.einsum('bcnhd,bcmhd->bchnm', qc, kc) * d_intra
    intra = jnp.einsum('bchnm,bcmhe->bcnhe', sc, vc)
    kv = jnp.einsum('bcmhd,bcmhe->bchde', kc * zeta.T[:, :, None], vc)

    def step(state, kv_c):
        return state * chunk_decay[None, :, None, None] + kv_c, state

    _, r_prev = lax.scan(step, jnp.zeros_like(kv[:, 0]), jnp.moveaxis(kv, 1, 0))
    cross = jnp.einsum('bcnhd,cbhde->bcnhe', qc * xi.T[:, :, None], r_prev)
    return (intra + cross).reshape(b_, s_, h, -1)


def retention_mixer(p, gn_g, gn_b):
    b_, s_, _ = p.shape
    q, k, v, g = jnp.split(p, 4, axis=-1)
    hd = lambda t: t.astype(jnp.float32).reshape(b_, s_, RET_HEADS, HEAD_DIM)
    q = rotary(hd(q))
    k = rotary(hd(k)) * (HEAD_DIM ** -0.5)
    y = retention_chunkwise(q, k, hd(v))
    y = head_group_norm(y, gn_g, gn_b, LN_EPS)
    return jax.nn.silu(g.astype(jnp.float32)) * y


def hybrid_mixer(x, w_in, w_out, mu, w0, w_up, a0, a_up, g_up, k_k, k_a, r_k, rln_g, rln_b,
                 gn_g, gn_b, rel_bias):
    p = x @ w_in
    p_rwkv, p_attn, p_ret = jnp.split(p, [RWKV_IN, RWKV_IN + ATTN_IN], axis=-1)
    y_a = rwkv7_time_mix(p_rwkv, mu, w0, w_up, a0, a_up, g_up, k_k, k_a, r_k, rln_g, rln_b)
    y_b = dilated_attention_mixture(p_attn, rel_bias)
    y_c = retention_mixer(p_ret, gn_g, gn_b)
    y = jnp.concatenate([y_a.astype(x.dtype), y_b.astype(x.dtype), y_c.astype(x.dtype)], axis=-1)
    return y @ w_out


def moe_ffn(x, router, wg, wu, wd):
    b_, s_, d = x.shape
    t = b_ * s_
    xt = x.reshape(t, d)
    logits = (xt @ router).astype(jnp.float32)
    top_val, top_idx = lax.top_k(logits, TOP_K)
    gates = jax.nn.softmax(top_val, axis=-1)
    e_flat = top_idx.reshape(-1)
    tok_flat = jnp.repeat(jnp.arange(t), TOP_K)
    g_flat = gates.reshape(-1)
    order = jnp.argsort(e_flat)
    e_sorted, tok_sorted, g_sorted = e_flat[order], tok_flat[order], g_flat[order]
    counts = jnp.bincount(e_flat, length=N_EXPERTS)
    starts = jnp.cumsum(counts) - counts
    padded = (counts + MOE_BLOCK - 1) // MOE_BLOCK * MOE_BLOCK
    pad_starts = jnp.cumsum(padded) - padded
    pad_ends = pad_starts + padded
    dest = pad_starts[e_sorted] + jnp.arange(t * TOP_K) - starts[e_sorted]
    rows = t * TOP_K + N_EXPERTS * MOE_BLOCK
    n_blk = rows // MOE_BLOCK
    buf = jnp.zeros((rows, d), x.dtype).at[dest].set(xt[tok_sorted])
    blk_e = jnp.minimum(jnp.searchsorted(pad_ends, jnp.arange(n_blk) * MOE_BLOCK, side='right'), N_EXPERTS - 1)

    def run(args):
        xb, e = args
        return swiglu(xb, wg[e], wu[e], wd[e])

    yb = lax.map(run, (buf.reshape(n_blk, MOE_BLOCK, d), blk_e)).reshape(rows, d)
    y_assign = yb[dest] * g_sorted[:, None].astype(yb.dtype)
    out = jnp.zeros((t, d), yb.dtype).at[tok_sorted].add(y_assign)
    return out.reshape(b_, s_, d)


def setup_inputs(seed: int = 0) -> dict:
    key = jax.random.key(seed)
    ks = jax.random.split(key, 27)
    f32 = jnp.float32
    nrm = lambda i, shape, scale: jax.random.normal(ks[i], shape, f32) * scale
    beta = DEEPNORM_BETA
    return {
        'x': nrm(0, (BATCH, SEQ, D_MODEL), 1.0),
        'w_in': nrm(1, (DEPTH, D_MODEL, N_IN), D_MODEL ** -0.5),
        'w_out': nrm(2, (DEPTH, D_MIX, D_MODEL), beta * D_MIX ** -0.5),
        'rwkv_mu': jax.random.uniform(ks[3], (DEPTH, RWKV_IN), f32),
        'rwkv_w0': jax.random.uniform(ks[4], (DEPTH, RWKV_DIM), f32, -4.0, 1.0),
        'rwkv_w_up': nrm(5, (DEPTH, DECAY_LORA, RWKV_DIM), 0.1),
        'rwkv_a0': nrm(6, (DEPTH, RWKV_DIM), 0.1),
        'rwkv_a_up': nrm(7, (DEPTH, ICL_LORA, RWKV_DIM), ICL_LORA ** -0.5),
        'rwkv_g_up': nrm(8, (DEPTH, GATE_LORA, RWKV_DIM), GATE_LORA ** -0.5),
        'rwkv_k_k': 0.85 + nrm(9, (DEPTH, RWKV_DIM), 0.05),
        'rwkv_k_a': 1.0 + nrm(10, (DEPTH, RWKV_DIM), 0.05),
        'rwkv_r_k': nrm(11, (DEPTH, RWKV_DIM), 0.1),
        'rwkv_ln_g': 1.0 + nrm(12, (DEPTH, RWKV_DIM), 0.02),
        'rwkv_ln_b': nrm(13, (DEPTH, RWKV_DIM), 0.02),
        'ret_gn_g': 1.0 + nrm(14, (DEPTH, RET_DIM), 0.02),
        'ret_gn_b': nrm(15, (DEPTH, RET_DIM), 0.02),
        'rel_bias': nrm(16, (NUM_BUCKETS, ATTN_HEADS), 0.2),
        'ln_g': 1.0 + nrm(17, (DEPTH, 2, D_MODEL), 0.02),
        'ln_b': nrm(18, (DEPTH, 2, D_MODEL), 0.02),
        'ffn_w_gate': nrm(19, (N_DENSE, D_MODEL, FF_DENSE), D_MODEL ** -0.5),
        'ffn_w_up': nrm(20, (N_DENSE, D_MODEL, FF_DENSE), D_MODEL ** -0.5),
        'ffn_w_down': nrm(21, (N_DENSE, FF_DENSE, D_MODEL), beta * FF_DENSE ** -0.5),
        'moe_router': nrm(22, (N_MOE, D_MODEL, N_EXPERTS), D_MODEL ** -0.5),
        'moe_w_gate': nrm(23, (N_MOE, N_EXPERTS, D_MODEL, FF_EXPERT), D_MODEL ** -0.5),
        'moe_w_up': nrm(24, (N_MOE, N_EXPERTS, D_MODEL, FF_EXPERT), D_MODEL ** -0.5),
        'moe_w_down': nrm(25, (N_MOE, N_EXPERTS, FF_EXPERT, D_MODEL), beta * FF_EXPERT ** -0.5),
    }


def reference(x, w_in, w_out, rwkv_mu, rwkv_w0, rwkv_w_up, rwkv_a0, rwkv_a_up, rwkv_g_up, rwkv_k_k,
              rwkv_k_a, rwkv_r_k, rwkv_ln_g, rwkv_ln_b, ret_gn_g, ret_gn_b, rel_bias, ln_g, ln_b,
              ffn_w_gate, ffn_w_up, ffn_w_down, moe_router, moe_w_gate, moe_w_up, moe_w_down):
    for layer in range(DEPTH):
        h = hybrid_mixer(x, w_in[layer], w_out[layer], rwkv_mu[layer], rwkv_w0[layer], rwkv_w_up[layer],
                         rwkv_a0[layer], rwkv_a_up[layer], rwkv_g_up[layer], rwkv_k_k[layer], rwkv_k_a[layer],
                         rwkv_r_k[layer], rwkv_ln_g[layer], rwkv_ln_b[layer], ret_gn_g[layer], ret_gn_b[layer],
                         rel_bias)
        x = layer_norm(DEEPNORM_ALPHA * x + h, ln_g[layer, 0], ln_b[layer, 0])
        j = layer // 2
        if layer % 2 == 0:
            f = swiglu(x, ffn_w_gate[j], ffn_w_up[j], ffn_w_down[j])
        else:
            f = moe_ffn(x, moe_router[j], moe_w_gate[j], moe_w_up[j], moe_w_down[j])
        x = layer_norm(DEEPNORM_ALPHA * x + f, ln_g[layer, 1], ln_b[layer, 1])
    return x
```

```cpp
#include <hip/hip_runtime.h>
#include <cstdio>
#include <cstdint>
namespace pg8 {
#define PG8_LAS __attribute__((address_space(3)))
typedef unsigned short bf16_t;
typedef short bf16x8 __attribute__((ext_vector_type(8)));
typedef float f32x4 __attribute__((ext_vector_type(4)));
typedef unsigned u32x4 __attribute__((ext_vector_type(4)));
constexpr int BM = 256, BK = 64, HALF = 128, HTB = HALF * BK * 2  , STAGE_BYTES = 8 * HTB, NXCD = 8, WGM = 8;

__host__ __device__ __forceinline__ int lds_byte(int r, int c) { const int st = (r >> 4) * 2 + (c >> 5), rr = r & 15, cc = c & 31, ob = rr * 64 + cc * 2; return st * 1024 + (ob ^ (((ob >> 9) & 1) << 5)); }
__host__ __device__ __forceinline__ void stage_rc(int b, int& R, int& C) { const int st = b / 1024, sb = b % 1024, swz = sb ^ (((sb >> 9) & 1) << 5); R = (st >> 1) * 16 + swz / 64; C = (st & 1) * 32 + (swz % 64) / 2; }
__host__ __device__ __forceinline__ int perm32(int rho) { const int n = rho >> 4, i = rho & 15; return 8 * (i >> 2) + 4 * n + (i & 3); }

struct Unit { int pm, pn; };
struct Gemm { const bf16_t* A; const bf16_t* Bt; int M, N, K; };

struct StaticOrder {
    int nM, nN, nwg, G, c;
    __host__ __device__ void init(int M, int N, int G_, int c_) { nM = M / BM; nN = N / BM; nwg = nM * nN; G = G_; c = c_; }
    __host__ __device__ bool next(int i, Unit& u) const {
        const long L = (long)i * G + c; if (L >= nwg) return false;
        int wgid = (int)L; { const int q = nwg / NXCD, r = nwg % NXCD, xcd = wgid % NXCD, off = wgid / NXCD; wgid = (xcd < r ? xcd * (q + 1) : r * (q + 1) + (xcd - r) * q) + off; }
        const int nig = WGM * nN, gid = wgid / nig, fm = gid * WGM, gsz = (nM - fm) < WGM ? (nM - fm) : WGM;
        u.pm = fm + ((wgid % nig) % gsz); u.pn = (wgid % nig) / gsz; return true;
    }
    __device__ __forceinline__ void a_ready(const Unit&) const {}
    __device__ __forceinline__ void done(const Unit&) const {}
    __device__ __forceinline__ size_t b_base_off(const Unit&) const { return 0; }
};

__device__ __forceinline__ unsigned cvt_pk_bf16(float lo, float hi) { unsigned r; asm volatile("v_cvt_pk_bf16_f32 %0, %1, %2" : "=v"(r) : "v"(lo), "v"(hi)); return r; }
typedef float f32x2 __attribute__((ext_vector_type(2)));
__device__ __forceinline__ f32x2 gelu_pk(f32x2 v) {
    const f32x2 av = __builtin_elementwise_abs(v), d = av * 0.2316418882f + 1.0f;
    f32x2 t; t.x = __builtin_amdgcn_rcpf(d.x); t.y = __builtin_amdgcn_rcpf(d.y);
    f32x2 q = t * 0.5307027145f + (-0.7265760135f); q = q * t + 0.7107068705f; q = q * t + (-0.142248368f); q = q * t + 0.127414796f; q = q * t;
    const f32x2 s = (v * v) * (-0.72134752044f);
    f32x2 e; e.x = __builtin_amdgcn_exp2f(s.x); e.y = __builtin_amdgcn_exp2f(s.y);
    const f32x2 m = v * (q * e), r = v - m;
    f32x2 o; o.x = v.x < 0.f ? m.x : r.x; o.y = v.y < 0.f ? m.y : r.y; return o;
}

template <int ACT  > struct EpiBf16 {
    static constexpr bool PERM = true, AFTER_DRAIN = false; static_assert(ACT == 0 || ACT == 1, "EpiBf16: ACT is 0 (none) or 1 (gelu_pk)");
    bf16_t* O; int ldc; const float* bias; int split_cols; size_t split_stride; float scale0;
    __device__ __forceinline__ void operator()(const f32x4 (&acc)[2][2][4][2], const Unit& u, int wr, int wc, int fr, int fq) const {
        const int row0 = u.pm * BM + wr * 64 + fr; int colt = u.pn * BM; bf16_t* base = O;
        float sc = 1.f; if (split_cols) { const int t = colt / split_cols; base += (size_t)t * split_stride; colt -= t * split_cols; if (t == 0) sc = scale0; }
        const int col0 = colt + wc * 32 + 8 * fq, bcol0 = u.pn * BM + wc * 32 + 8 * fq;
        f32x4 bv[2][2];
#pragma unroll
        for (int bj = 0; bj < 2; ++bj)
#pragma unroll
            for (int n = 0; n < 2; ++n) bv[bj][n] = bias ? *(const f32x4*)(bias + bcol0 + bj * HALF + 4 * n) : (f32x4){0.f, 0.f, 0.f, 0.f};
#pragma unroll
        for (int ai = 0; ai < 2; ++ai)
#pragma unroll
            for (int m = 0; m < 4; ++m) { bf16_t* rowp = base + (size_t)(row0 + ai * HALF + m * 16) * ldc + col0;
#pragma unroll
                for (int bj = 0; bj < 2; ++bj) { f32x4 v0 = acc[ai][bj][m][0] + bv[bj][0], v1 = acc[ai][bj][m][1] + bv[bj][1];
                    if (ACT == 1) { f32x2 a = gelu_pk((f32x2){v0[0], v0[1]}), b = gelu_pk((f32x2){v0[2], v0[3]}), c = gelu_pk((f32x2){v1[0], v1[1]}), d = gelu_pk((f32x2){v1[2], v1[3]});
                        v0 = (f32x4){a.x, a.y, b.x, b.y}; v1 = (f32x4){c.x, c.y, d.x, d.y}; }
                    v0 = v0 * sc; v1 = v1 * sc; u32x4 w; w.x = cvt_pk_bf16(v0[0], v0[1]); w.y = cvt_pk_bf16(v0[2], v0[3]); w.z = cvt_pk_bf16(v1[0], v1[1]); w.w = cvt_pk_bf16(v1[2], v1[3]);
                    *(u32x4*)(rowp + bj * HALF) = w; } }
    }
};

struct PanelStats {
    unsigned* xbuf;
    unsigned* cnt;
    unsigned* tmo;
    int ntn; float eps;
    unsigned code;
    __device__ __forceinline__ bool run(const f32x4 (&v)[2][2][4][2], const Unit& u, int wr, int wc, int fr, int fq, PG8_LAS unsigned char* lds, int wid, int lane) const {
        typedef float f32x2v __attribute__((ext_vector_type(2)));
        PG8_LAS f32x2v* P = (PG8_LAS f32x2v*)lds;
        PG8_LAS f32x2v* S = (PG8_LAS f32x2v*)(lds + 8192);
        PG8_LAS unsigned* flag = (PG8_LAS unsigned*)(lds + 8192 + 2048);
#pragma unroll
        for (int ai = 0; ai < 2; ++ai)
#pragma unroll
            for (int m = 0; m < 4; ++m) {
                float s = 0.f;
#pragma unroll
                for (int bj = 0; bj < 2; ++bj)
#pragma unroll
                    for (int n = 0; n < 2; ++n) { const f32x4 x = v[ai][bj][m][n]; s += (x[0] + x[1]) + (x[2] + x[3]); }
                s += __shfl_xor(s, 16); s += __shfl_xor(s, 32);
                const float mw = s * (1.0f / 64.0f); float q = 0.f;
#pragma unroll
                for (int bj = 0; bj < 2; ++bj)
#pragma unroll
                    for (int n = 0; n < 2; ++n) { const f32x4 d = v[ai][bj][m][n] - mw; q += (d[0] * d[0] + d[1] * d[1]) + (d[2] * d[2] + d[3] * d[3]); }
                q += __shfl_xor(q, 16); q += __shfl_xor(q, 32);
                if (fq == 0) P[(ai * HALF + wr * 64 + m * 16 + fr) * 4 + wc] = (f32x2v){mw, q};
            }
        asm volatile("s_waitcnt lgkmcnt(0)" ::: "memory"); __builtin_amdgcn_s_barrier(); asm volatile("" ::: "memory");
#if defined(BROKEN_EXCHANGE_NO_WAIT)
#warning BROKEN CONTROL BUILD: the row-statistics exchange does not wait; results are wrong by design
        if (blockIdx.x >= 64) { const long long t0_ = clock64(); while (clock64() - t0_ < 60000) __builtin_amdgcn_s_sleep(8); }
#endif
        const int row = wid * 32 + (lane & 31);
        if (lane < 32) {
            const f32x2v a = P[row * 4 + 0], b = P[row * 4 + 1], c = P[row * 4 + 2], d = P[row * 4 + 3];
            const float mt = (a.x + b.x + c.x + d.x) * 0.25f;
            const float da = a.x - mt, db = b.x - mt, dc = c.x - mt, dd = d.x - mt;
            const float m2 = (a.y + b.y) + (c.y + d.y) + 64.0f * ((da * da + db * db) + (dc * dc + dd * dd));
            unsigned long long* slot = (unsigned long long*)xbuf + ((size_t)(u.pm * BM + row) * 4 + u.pn);
            __hip_atomic_store(slot, ((unsigned long long)__float_as_uint(m2) << 32) | __float_as_uint(mt), __ATOMIC_RELAXED, __HIP_MEMORY_SCOPE_AGENT);
        }
        asm volatile("s_waitcnt vmcnt(0)" ::: "memory");
        if (lane == 0) __hip_atomic_fetch_add(cnt + 64 * u.pm, 1u, __ATOMIC_RELAXED, __HIP_MEMORY_SCOPE_AGENT);
        if (wid == 0) {
            bool dead = false; const unsigned long long t0 = __builtin_amdgcn_s_memrealtime(); const unsigned want = 8u * (unsigned)ntn;
            for (;;) {
#if defined(BROKEN_EXCHANGE_NO_WAIT)
                break;
#endif
                if ((unsigned)__builtin_amdgcn_readfirstlane(__hip_atomic_load(cnt + 64 * u.pm, __ATOMIC_RELAXED, __HIP_MEMORY_SCOPE_AGENT)) >= want) break;
                if (__builtin_amdgcn_s_memrealtime() - t0 > 2000000ull) {
                    if (lane == 0) { unsigned expect = 0u; __hip_atomic_compare_exchange_strong(tmo + 1, &expect, code | (unsigned)(u.pm & 0xff), __ATOMIC_RELAXED, __ATOMIC_RELAXED, __HIP_MEMORY_SCOPE_AGENT);
                                     __hip_atomic_store(tmo, 1u, __ATOMIC_RELAXED, __HIP_MEMORY_SCOPE_AGENT); }
                    dead = true; break; }
                __builtin_amdgcn_s_sleep(2);
            }
            __builtin_amdgcn_fence(__ATOMIC_ACQUIRE, "agent");
            if (lane == 0) flag[0] = dead ? 1u : 0u;
        }
        asm volatile("s_waitcnt vmcnt(0) lgkmcnt(0)" ::: "memory"); __builtin_amdgcn_s_barrier(); asm volatile("" ::: "memory");
        const bool bad = flag[0] != 0u;
        if (lane < 32) {
            const unsigned long long* slot = (const unsigned long long*)xbuf + (size_t)(u.pm * BM + row) * 4; float mt[4], m2[4]; float ms = 0.f;
#pragma unroll
            for (int t = 0; t < 4; ++t) { if (t < ntn) { const unsigned long long w = __hip_atomic_load(slot + t, __ATOMIC_RELAXED, __HIP_MEMORY_SCOPE_AGENT); mt[t] = __uint_as_float((unsigned)w); m2[t] = __uint_as_float((unsigned)(w >> 32)); } else { mt[t] = 0.f; m2[t] = 0.f; } ms += mt[t]; }
            const float mean = ms / (float)ntn; float q = 0.f;
#pragma unroll
            for (int t = 0; t < 4; ++t) if (t < ntn) { const float dm = mt[t] - mean; q += m2[t] + 256.0f * dm * dm; }
            S[row] = (f32x2v){mean, 1.0f / sqrtf(q / (256.0f * (float)ntn) + eps)};
        }
        asm volatile("s_waitcnt lgkmcnt(0)" ::: "memory"); __builtin_amdgcn_s_barrier(); asm volatile("" ::: "memory");
        return bad;
    }
};
struct EpiLnRes {
    static constexpr bool PERM = false, AFTER_DRAIN = true;
    const float* base; float* out; int ldc; const float* bias; PanelStats st; unsigned poison;
    __device__ __forceinline__ void fused(f32x4 (&acc)[2][2][4][2], const Unit& u, int wr, int wc, int fr, int fq, PG8_LAS unsigned char* lds, int wid, int lane) const {
        typedef float f32x2v __attribute__((ext_vector_type(2)));
        const PG8_LAS f32x2v* S = (const PG8_LAS f32x2v*)(lds + 8192);
        const int col0 = u.pn * BM + wc * 32 + 4 * fq;
#pragma unroll
        for (int bj = 0; bj < 2; ++bj)
#pragma unroll
            for (int n = 0; n < 2; ++n) { const f32x4 bv = bias ? *(const f32x4*)(bias + col0 + bj * HALF + n * 16) : (f32x4){0.f, 0.f, 0.f, 0.f};
#pragma unroll
                for (int ai = 0; ai < 2; ++ai)
#pragma unroll
                    for (int m = 0; m < 4; ++m) acc[ai][bj][m][n] += bv; }
        f32x4 pre[4][2][2];
#pragma unroll
        for (int m = 0; m < 4; ++m) { const size_t off = (size_t)(u.pm * BM + wr * 64 + m * 16 + fr) * ldc + col0;
#pragma unroll
            for (int bj = 0; bj < 2; ++bj)
#pragma unroll
                for (int n = 0; n < 2; ++n) pre[m][bj][n] = *(const f32x4*)(base + off + bj * HALF + n * 16); }
        const bool bad = st.run(acc, u, wr, wc, fr, fq, lds, wid, lane) || poison != 0u;
        const float qnan = __builtin_nanf("");
#pragma unroll
        for (int ai = 0; ai < 2; ++ai)
#pragma unroll
            for (int m = 0; m < 4; ++m) { const int r = ai * HALF + wr * 64 + m * 16 + fr; const f32x2v sr = S[r]; const size_t off = (size_t)(u.pm * BM + r) * ldc + col0;
#pragma unroll
                for (int bj = 0; bj < 2; ++bj)
#pragma unroll
                    for (int n = 0; n < 2; ++n) { const f32x4 bs = ai == 0 ? pre[m][bj][n] : *(const f32x4*)(base + off + bj * HALF + n * 16); f32x4 o = bs + (acc[ai][bj][m][n] - sr.x) * sr.y;
                        if (bad) o = (f32x4){qnan, qnan, qnan, qnan}; *(f32x4*)(out + off + bj * HALF + n * 16) = o; }
                if (m & 1) asm volatile("" ::: "memory"); }
    }
};
struct EpiLnResLn {
    static constexpr bool PERM = false, AFTER_DRAIN = true;
    const float* base; float* out; bf16_t* xn; int ldc; const float* bias; PanelStats st1, st2; unsigned poison;
    __device__ __forceinline__ void fused(f32x4 (&acc)[2][2][4][2], const Unit& u, int wr, int wc, int fr, int fq, PG8_LAS unsigned char* lds, int wid, int lane) const {
        typedef float f32x2v __attribute__((ext_vector_type(2))); typedef unsigned u32x2v __attribute__((ext_vector_type(2)));
        const PG8_LAS f32x2v* S = (const PG8_LAS f32x2v*)(lds + 8192);
        const int col0 = u.pn * BM + wc * 32 + 4 * fq;
#pragma unroll
        for (int bj = 0; bj < 2; ++bj)
#pragma unroll
            for (int n = 0; n < 2; ++n) { const f32x4 bv = bias ? *(const f32x4*)(bias + col0 + bj * HALF + n * 16) : (f32x4){0.f, 0.f, 0.f, 0.f};
#pragma unroll
                for (int ai = 0; ai < 2; ++ai)
#pragma unroll
                    for (int m = 0; m < 4; ++m) acc[ai][bj][m][n] += bv; }
        bool bad = st1.run(acc, u, wr, wc, fr, fq, lds, wid, lane) || poison != 0u;
        const float qnan = __builtin_nanf("");
#pragma unroll
        for (int ai = 0; ai < 2; ++ai)
#pragma unroll
            for (int m = 0; m < 4; ++m) { const int r = ai * HALF + wr * 64 + m * 16 + fr; const f32x2v sr = S[r]; const size_t off = (size_t)(u.pm * BM + r) * ldc + col0;
#pragma unroll
                for (int bj = 0; bj < 2; ++bj)
#pragma unroll
                    for (int n = 0; n < 2; ++n) { const f32x4 bs = *(const f32x4*)(base + off + bj * HALF + n * 16); acc[ai][bj][m][n] = bs + (acc[ai][bj][m][n] - sr.x) * sr.y; }
                asm volatile("" : "+v"(acc[ai][0][m][0]), "+v"(acc[ai][0][m][1]), "+v"(acc[ai][1][m][0]), "+v"(acc[ai][1][m][1]));
                if (m & 1) asm volatile("" ::: "memory"); }
        const bool bad1 = bad;
        bad = st2.run(acc, u, wr, wc, fr, fq, lds, wid, lane) || bad;
#pragma unroll
        for (int ai = 0; ai < 2; ++ai)
#pragma unroll
            for (int m = 0; m < 4; ++m) { const int r = ai * HALF + wr * 64 + m * 16 + fr; const f32x2v sr = S[r]; const size_t off = (size_t)(u.pm * BM + r) * ldc + col0;
#pragma unroll
                for (int bj = 0; bj < 2; ++bj)
#pragma unroll
                    for (int n = 0; n < 2; ++n) { const f32x4 x1 = acc[ai][bj][m][n]; *(f32x4*)(out + off + bj * HALF + n * 16) = bad1 ? (f32x4){qnan, qnan, qnan, qnan} : x1;
                        const f32x4 o = (x1 - sr.x) * sr.y; u32x2v w; w.x = cvt_pk_bf16(o[0], o[1]); w.y = cvt_pk_bf16(o[2], o[3]);
                        if (bad) { w.x = 0x7fc07fc0u; w.y = 0x7fc07fc0u; } *(u32x2v*)(xn + off + bj * HALF + n * 16) = w; }
                asm volatile("" ::: "memory"); }
    }
};

template <class Epi, class Sched, bool ALIGN_EPI = false, bool SP2 = false>
__device__ __forceinline__ void gemm_phase(PG8_LAS unsigned char* lds, const Gemm g, const Sched& S, const Epi& E) {
    int tid_ = threadIdx.x; asm volatile("" : "+v"(tid_));
    const int tid = tid_, wid = __builtin_amdgcn_readfirstlane(tid >> 6), lane = tid & 63, wr = wid >> 2, wc = wid & 3, fr = lane & 15, fq = lane >> 4;
    const int K = g.K, nt = K / BK;
    unsigned voffA[2], voffB[2];
#pragma unroll
    for (int i = 0; i < 2; ++i) { int R, C; stage_rc(tid * 16 + i * 8192, R, C); const int Rb = Epi::PERM ? ((R & ~31) + perm32(R & 31)) : R;
        voffA[i] = (unsigned)(R * K + C) * 2u; voffB[i] = (unsigned)(Rb * K + C) * 2u; }
    const size_t kstep = (size_t)(BK * 2);
    const size_t hstep = (size_t)HALF * K * 2;
    const size_t tstep = 2 * hstep;
    const unsigned ldsw = (unsigned)wid * 1024u;
    const int aoff = lds_byte(wr * 64 + fr, fq * 8), boff = lds_byte(wc * 32 + fr, fq * 8);
#define PG8_SA(b, h) (((b) * 2 + (h)) * HTB)
#define PG8_SB(b, h) ((4 + (b) * 2 + (h)) * HTB)
#define PG8_STAGE(bufoff, gbase, voff) do { _Pragma("unroll") for (int _i = 0; _i < 2; ++_i) \
        __builtin_amdgcn_global_load_lds((const unsigned*)((const char*)(gbase) + (voff)[_i]), (PG8_LAS unsigned*)(lds + (bufoff) + ldsw + _i * 8192), 16, 0, 0); } while (0)
#define PG8_LDA(dst, b, h) do { _Pragma("unroll") for (int m = 0; m < 4; ++m) _Pragma("unroll") for (int k = 0; k < 2; ++k) dst[m][k] = *(const PG8_LAS bf16x8*)(lds + PG8_SA(b, h) + aoff + m * 2048 + k * 1024); } while (0)
#define PG8_LDB(dst, b, h) do { _Pragma("unroll") for (int n = 0; n < 2; ++n) _Pragma("unroll") for (int k = 0; k < 2; ++k) dst[n][k] = *(const PG8_LAS bf16x8*)(lds + PG8_SB(b, h) + boff + n * 2048 + k * 1024); } while (0)
#define PG8_MMA(ai, bj, At, Bt) do { __builtin_amdgcn_s_setprio(1); _Pragma("unroll") for (int m = 0; m < 4; ++m) _Pragma("unroll") for (int n = 0; n < 2; ++n) _Pragma("unroll") for (int k = 0; k < 2; ++k) \
        acc[ai][bj][m][n] = __builtin_amdgcn_mfma_f32_16x16x32_bf16(Bt[n][k], At[m][k], acc[ai][bj][m][n], 0, 0, 0); __builtin_amdgcn_s_setprio(0); } while (0)
#define PG8_WAIT_V(n) asm volatile("s_waitcnt vmcnt(" #n ")" ::: "memory")
#define PG8_WAIT_L(n) asm volatile("s_waitcnt lgkmcnt(" #n ")" ::: "memory")
#define PG8_BAR __builtin_amdgcn_s_barrier()
#define PG8_SCHED __builtin_amdgcn_sched_barrier(0)
    Unit cur, nxt; int ui = 0;
    if (!S.next(0, cur)) return;
    f32x4 acc[2][2][4][2];
#pragma unroll
    for (int a = 0; a < 2; ++a)
#pragma unroll
        for (int b = 0; b < 2; ++b)
#pragma unroll
            for (int m = 0; m < 4; ++m)
#pragma unroll
                for (int n = 0; n < 2; ++n) acc[a][b][m][n] = (f32x4){0.f, 0.f, 0.f, 0.f};
    bf16x8 At[4][2], B0[2][2], B1[2][2];
    const char* cA = (const char*)g.A + (size_t)cur.pm * tstep; const char* cB = (const char*)g.Bt + S.b_base_off(cur) + (size_t)cur.pn * tstep;
    S.a_ready(cur);
    if constexpr (SP2) {
        PG8_STAGE(PG8_SB(0, 0), cB, voffB); PG8_STAGE(PG8_SB(0, 1), cB + hstep, voffB); PG8_STAGE(PG8_SA(0, 0), cA, voffA); PG8_STAGE(PG8_SA(0, 1), cA + hstep, voffA);
        if (wr == 1) PG8_BAR;
        PG8_WAIT_V(2); PG8_BAR;
        PG8_STAGE(PG8_SB(1, 0), cB + kstep, voffB); PG8_STAGE(PG8_SA(1, 0), cA + kstep, voffA); PG8_STAGE(PG8_SB(1, 1), cB + hstep + kstep, voffB);
        PG8_WAIT_V(6); PG8_BAR;
    } else {
        PG8_STAGE(PG8_SB(0, 0), cB, voffB); PG8_STAGE(PG8_SA(0, 0), cA, voffA); PG8_STAGE(PG8_SB(0, 1), cB + hstep, voffB); PG8_STAGE(PG8_SA(0, 1), cA + hstep, voffA);
        if (wr == 1) PG8_BAR;
        PG8_WAIT_V(4); PG8_BAR;
        PG8_STAGE(PG8_SB(1, 0), cB + kstep, voffB); PG8_STAGE(PG8_SA(1, 0), cA + kstep, voffA); PG8_STAGE(PG8_SB(1, 1), cB + hstep + kstep, voffB);
        PG8_WAIT_V(6); PG8_BAR;
    }
    for (;;) {
        const bool has_next = S.next(ui + 1, nxt);
        const char* nA = has_next ? (const char*)g.A + (size_t)nxt.pm * tstep : cA; const char* nB = has_next ? (const char*)g.Bt + S.b_base_off(nxt) + (size_t)nxt.pn * tstep : cB;
        for (int t = 0; t < nt; t += 2) {
            const bool last = (t == nt - 2);
            const char* a1 = cA + (size_t)(t + 1) * kstep;
            const char* a2 = last ? nA : cA + (size_t)(t + 2) * kstep; const char* b2 = last ? nB : cB + (size_t)(t + 2) * kstep;
            const char* a3 = a2 + kstep; const char* b3 = b2 + kstep;
            if (last && has_next) S.a_ready(nxt);
            if constexpr (SP2) {
            PG8_LDB(B0, 0, 0); PG8_LDB(B1, 0, 1); PG8_SCHED; PG8_LDA(At, 0, 0); PG8_STAGE(PG8_SA(1, 1), a1 + hstep, voffA);
            PG8_WAIT_V(8); PG8_WAIT_L(0); PG8_BAR; PG8_MMA(0, 0, At, B0); PG8_MMA(0, 1, At, B1); PG8_BAR; PG8_SCHED;
            PG8_LDA(At, 0, 1); PG8_STAGE(PG8_SB(0, 0), b2, voffB); PG8_STAGE(PG8_SB(0, 1), b2 + hstep, voffB); PG8_STAGE(PG8_SA(0, 0), a2, voffA);
            PG8_WAIT_V(8); PG8_WAIT_L(0); PG8_BAR; PG8_MMA(1, 0, At, B0); PG8_MMA(1, 1, At, B1); PG8_BAR; PG8_SCHED;
            PG8_LDB(B0, 1, 0); PG8_LDB(B1, 1, 1); PG8_SCHED; PG8_LDA(At, 1, 0); PG8_STAGE(PG8_SA(0, 1), a2 + hstep, voffA);
            PG8_WAIT_V(8); PG8_WAIT_L(0); PG8_BAR; PG8_MMA(0, 0, At, B0); PG8_MMA(0, 1, At, B1); PG8_BAR; PG8_SCHED;
            PG8_LDA(At, 1, 1); PG8_STAGE(PG8_SB(1, 0), b3, voffB); PG8_STAGE(PG8_SB(1, 1), b3 + hstep, voffB); PG8_STAGE(PG8_SA(1, 0), a3, voffA);
            PG8_WAIT_V(8); PG8_WAIT_L(0); PG8_BAR; PG8_MMA(1, 0, At, B0); PG8_MMA(1, 1, At, B1); PG8_BAR; PG8_SCHED;
            } else {
            PG8_LDB(B0, 0, 0); PG8_SCHED; PG8_LDA(At, 0, 0); PG8_STAGE(PG8_SA(1, 1), a1 + hstep, voffA);
            PG8_WAIT_L(8); PG8_BAR; PG8_WAIT_L(0); PG8_MMA(0, 0, At, B0); PG8_BAR; PG8_SCHED;
            PG8_LDB(B1, 0, 1); PG8_STAGE(PG8_SB(0, 0), b2, voffB);
            PG8_BAR; PG8_WAIT_L(0); PG8_MMA(0, 1, At, B1); PG8_BAR;
            PG8_LDA(At, 0, 1); PG8_STAGE(PG8_SA(0, 0), a2, voffA);
            PG8_BAR; PG8_WAIT_L(0); PG8_MMA(1, 0, At, B0); PG8_BAR; PG8_SCHED;
            PG8_STAGE(PG8_SB(0, 1), b2 + hstep, voffB);
            PG8_WAIT_V(6); PG8_BAR; PG8_MMA(1, 1, At, B1); PG8_BAR;
            PG8_LDB(B0, 1, 0); PG8_SCHED; PG8_LDA(At, 1, 0); PG8_STAGE(PG8_SA(0, 1), a2 + hstep, voffA);
            PG8_WAIT_L(8); PG8_BAR; PG8_WAIT_L(0); PG8_MMA(0, 0, At, B0); PG8_BAR; PG8_SCHED;
            PG8_LDB(B1, 1, 1); PG8_STAGE(PG8_SB(1, 0), b3, voffB);
            PG8_BAR; PG8_WAIT_L(0); PG8_MMA(0, 1, At, B1); PG8_BAR;
            PG8_LDA(At, 1, 1); PG8_STAGE(PG8_SA(1, 0), a3, voffA);
            PG8_BAR; PG8_WAIT_L(0); PG8_MMA(1, 0, At, B0); PG8_BAR; PG8_SCHED;
            PG8_STAGE(PG8_SB(1, 1), b3 + hstep, voffB);
            PG8_WAIT_V(6); PG8_BAR; PG8_MMA(1, 1, At, B1); PG8_BAR;
            }
        }
        if constexpr (ALIGN_EPI) { if (wr == 0) PG8_BAR; }
        if constexpr (!Epi::AFTER_DRAIN) { E(acc, cur, wr, wc, fr, fq); S.done(cur); }
        if (!has_next) break;
#pragma unroll
        for (int a = 0; a < 2; ++a)
#pragma unroll
            for (int b = 0; b < 2; ++b)
#pragma unroll
                for (int m = 0; m < 4; ++m)
#pragma unroll
                    for (int n = 0; n < 2; ++n) acc[a][b][m][n] = (f32x4){0.f, 0.f, 0.f, 0.f};
        cur = nxt; cA = nA; cB = nB; ++ui;
        if constexpr (ALIGN_EPI) { if (wr == 1) PG8_BAR; }
    }
    PG8_WAIT_V(0);
    if constexpr (!ALIGN_EPI) { if (wr == 0) PG8_BAR; }
    PG8_BAR;
    if constexpr (Epi::AFTER_DRAIN) { E.fused(acc, cur, wr, wc, fr, fq, lds, wid, lane); S.done(cur); }
#undef PG8_SA
#undef PG8_SB
#undef PG8_STAGE
#undef PG8_LDA
#undef PG8_LDB
#undef PG8_MMA
#undef PG8_WAIT_V
#undef PG8_WAIT_L
#undef PG8_BAR
#undef PG8_SCHED
}
}

namespace pg8 {
struct EpiF32 {
    static constexpr bool PERM = false, AFTER_DRAIN = false;
    float* O; int ldc;
    __device__ __forceinline__ void operator()(const f32x4 (&acc)[2][2][4][2], const Unit& u, int wr, int wc, int fr, int fq) const {
        const int row0 = u.pm * BM + wr * 64 + fr, col0 = u.pn * BM + wc * 32 + 4 * fq;
#pragma unroll
        for (int ai = 0; ai < 2; ++ai)
#pragma unroll
            for (int m = 0; m < 4; ++m) { float* rowp = O + (size_t)(row0 + ai * HALF + m * 16) * ldc + col0;
#pragma unroll
                for (int bj = 0; bj < 2; ++bj)
#pragma unroll
                    for (int n = 0; n < 2; ++n) *(f32x4*)(rowp + bj * HALF + n * 16) = acc[ai][bj][m][n]; }
    }
};
__device__ __forceinline__ float silu_mul(float g, float u) { return g * __builtin_amdgcn_rcpf(1.0f + __expf(-g)) * u; }
struct EpiSwiglu {
    static constexpr bool PERM = true, AFTER_DRAIN = false;
    bf16_t* O; int ldc;
    __device__ __forceinline__ void operator()(const f32x4 (&acc)[2][2][4][2], const Unit& u, int wr, int wc, int fr, int fq) const {
        const int row0 = u.pm * BM + wr * 64 + fr, col0 = u.pn * HALF + wc * 32 + 8 * fq;
#pragma unroll
        for (int ai = 0; ai < 2; ++ai)
#pragma unroll
            for (int m = 0; m < 4; ++m) { bf16_t* rowp = O + (size_t)(row0 + ai * HALF + m * 16) * ldc + col0;
                const f32x4 g0 = acc[ai][0][m][0], g1 = acc[ai][0][m][1], u0 = acc[ai][1][m][0], u1 = acc[ai][1][m][1];
                u32x4 w;
                w.x = cvt_pk_bf16(silu_mul(g0[0], u0[0]), silu_mul(g0[1], u0[1])); w.y = cvt_pk_bf16(silu_mul(g0[2], u0[2]), silu_mul(g0[3], u0[3]));
                w.z = cvt_pk_bf16(silu_mul(g1[0], u1[0]), silu_mul(g1[1], u1[1])); w.w = cvt_pk_bf16(silu_mul(g1[2], u1[2]), silu_mul(g1[3], u1[3]));
                *(u32x4*)rowp = w; }
    }
};
struct MoeOrder : StaticOrder {
    int pm_off; int pend[8]; size_t estride;
    __device__ __forceinline__ size_t b_base_off(const Unit& u) const {
        const int rb = (u.pm + pm_off) * BM; int e = 0;
#pragma unroll
        for (int k = 0; k < 7; ++k) e += (rb >= pend[k]) ? 1 : 0;
        return (size_t)e * estride;
    }
};
}

constexpr int NWAVES = 8, NTHR = 512;
constexpr int NB = 8, SEQ = 4096, D = 1024, T = NB * SEQ, DEPTH = 4;
constexpr int NIN = 3584;
constexpr int C_AQ = 1024, C_AK = 1536, C_AV = 2048, C_RQ = 2560, C_RK = 2816, C_RV = 3072, C_RG = 3328;
constexpr int FFD = 2816, FFE = 3584, NE = 8;
constexpr int MOE_ROWS = 2 * T + NE * 256;
constexpr int HID_HALF_BLKS = 132;
constexpr float LN_EPS = 1e-5f, ALPHA = 1.681792830507429f;

constexpr size_t MiB = 1u << 20;
constexpr size_t WS_CTL = 0, CTL_ZERO_BYTES = 1 * MiB;
constexpr size_t WS_TAB = 1 * MiB;
constexpr size_t WS_WIN = 4 * MiB, WS_WOUT = 32 * MiB, WS_WGU = 40 * MiB, WS_WD = 62 * MiB, WS_WGUE = 73 * MiB, WS_WDE = 185 * MiB;
constexpr size_t WS_XB = 241 * MiB, WS_SH = 305 * MiB, WS_END = 817 * MiB;
constexpr size_t SH_P = 0, SH_SCR = 224 * MiB, SH_Y = 448 * MiB;
constexpr size_t SH_H = 0, SH_HID = 128 * MiB, SH_XG = 359 * MiB, SH_TOK = 491 * MiB;
static_assert((size_t)HID_HALF_BLKS * 256 * FFE * 2 <= 231 * MiB && (size_t)T * FFD * 2 <= 231 * MiB && (size_t)MOE_ROWS * D * 2 <= 132 * MiB, "ffn buffers");
constexpr int CW_BAR = 4096;
constexpr int TAB_BIAS = 0, TAB_COS = 4096, TAB_SIN = 4096 + 4096 * 32, TAB_META = 4096 + 2 * 4096 * 32;
constexpr size_t TOK_TI = 0, TOK_TG = (size_t)T * 16, TOK_TP = TOK_TG + (size_t)T * 8, TOK_CW = TOK_TP + (size_t)T * 8;

constexpr int RING_OFF = 0, RING_BYTES = 131072, LDSCTL_OFF = RING_BYTES, MISC_OFF = LDSCTL_OFF + 320, LDS_BYTES = 147456;

#define GAS __attribute__((address_space(1)))
#define LAS __attribute__((address_space(3)))
typedef unsigned short bf16;
typedef unsigned v4u __attribute__((ext_vector_type(4)));
typedef unsigned v2u __attribute__((ext_vector_type(2)));
typedef int v4i __attribute__((ext_vector_type(4)));
typedef int v2i __attribute__((ext_vector_type(2)));
typedef float f32x4 __attribute__((ext_vector_type(4)));
typedef float f32x2 __attribute__((ext_vector_type(2)));
typedef GAS unsigned gu32;
#define RLX_AGENT __ATOMIC_RELAXED, __HIP_MEMORY_SCOPE_AGENT
#define LDS_WAIT() asm volatile("s_waitcnt lgkmcnt(0)" ::: "memory")
#define VM_WAIT() asm volatile("s_waitcnt vmcnt(0)" ::: "memory")
__device__ __forceinline__ unsigned f2bf(float f) { unsigned u = __builtin_bit_cast(unsigned, f); return (u + 0x7fffu + ((u >> 16) & 1u)) >> 16; }
__device__ __forceinline__ unsigned pk2(float lo, float hi) { return f2bf(lo) | (f2bf(hi) << 16); }
__device__ __forceinline__ float bflo(unsigned u) { return __builtin_bit_cast(float, u << 16); }
__device__ __forceinline__ float bfhi(unsigned u) { return __builtin_bit_cast(float, u & 0xffff0000u); }
__device__ __forceinline__ float bf2f(bf16 v) { return __builtin_bit_cast(float, (unsigned)v << 16); }
__device__ __forceinline__ float sigm(float x) { return 1.0f / (1.0f + __expf(-x)); }
__device__ __forceinline__ float rdl(float v, int l) { return __builtin_bit_cast(float, __builtin_amdgcn_readlane(__builtin_bit_cast(int, v), l)); }
__device__ __forceinline__ float wave_sum(float v) {
#pragma unroll
    for (int o = 1; o < 64; o <<= 1) v += __shfl_xor(v, o);
    return v;
}

#define XB_TMO      128
#define XB_XCNT(j)  (256  + 64 * (j))
#define XB_XSUB(j)  (1280 + 64 * (j))
#define XB_XGEN(j)  (2304 + 64 * (j))
#define XB_TOP      3328
#define XB_TOPGEN   3392
#define XCD_BAR_WORDS 3456
#define XB_SPIN_CAP (1u << 18)

__device__ __forceinline__ unsigned xb_ld(unsigned* p)              { return __hip_atomic_load(p, __ATOMIC_RELAXED, __HIP_MEMORY_SCOPE_AGENT); }
__device__ __forceinline__ unsigned xb_add(unsigned* p, unsigned v) { return __hip_atomic_fetch_add(p, v, __ATOMIC_RELAXED, __HIP_MEMORY_SCOPE_AGENT); }
__device__ __forceinline__ unsigned xb_xcc_id() { return (unsigned)__builtin_amdgcn_s_getreg((3 << 11) | 20) & 0xFu; }
#define XB_SPIN(cond, bar) do { unsigned _sp = 0; while (cond) { __builtin_amdgcn_s_sleep(1); \
    if ((++_sp & 255u) == 0u) { if (xb_ld(&(bar)[XB_TMO])) break; if (_sp > XB_SPIN_CAP) { atomicAdd(&(bar)[XB_TMO], 1u); break; } } } } while (0)

struct XcdBarrier {
    unsigned* bar; unsigned x;
    volatile LAS unsigned* st;
};

__device__ __forceinline__ XcdBarrier xcd_barrier_post(unsigned* bar, volatile LAS unsigned* st) {
    XcdBarrier b; b.bar = bar; b.x = xb_xcc_id(); b.st = st;
    if (threadIdx.x == 0) (void)xb_add(&bar[XB_XCNT(b.x)], 1u);
    return b;
}
__device__ __forceinline__ void xcd_barrier_complete(unsigned* bar, unsigned x, unsigned& nloc, unsigned& nx) {
    const unsigned G = gridDim.x * gridDim.y * gridDim.z;
    unsigned sum, cnt, mine, sp = 0u;
    for (;;) {
        sum = 0u; cnt = 0u; mine = 0u;
#pragma unroll
        for (unsigned j = 0; j < 16; ++j) { const unsigned c = xb_ld(&bar[XB_XCNT(j)]); sum += c; cnt += (c > 0u) ? 1u : 0u; mine = (j == x) ? c : mine; }
        if (sum == G) break;
        __builtin_amdgcn_s_sleep(1);
        if ((++sp & 255u) == 0u) { if (xb_ld(&bar[XB_TMO])) break; if (sp > XB_SPIN_CAP) { atomicAdd(&bar[XB_TMO], 1u); break; } }
    }
    nloc = mine > 0u ? mine : 1u; nx = cnt > 0u ? cnt : 1u;
}

__device__ __forceinline__ void xcd_barrier(const XcdBarrier& b) {
    asm volatile("s_waitcnt vmcnt(0)" ::: "memory");
    __syncthreads();
    if (threadIdx.x == 0) {
        unsigned* bar = b.bar;
        __builtin_amdgcn_s_waitcnt(0);
        unsigned nloc = b.st[0], nx = b.st[1];
        if (nloc == 0u) { xcd_barrier_complete(bar, b.x, nloc, nx); b.st[0] = nloc; b.st[1] = nx; }
        const unsigned old = xb_add(&bar[XB_XSUB(b.x)], 1u);
        const unsigned gen = old / nloc;
        if (old + 1u == (gen + 1u) * nloc) {
            __builtin_amdgcn_fence(__ATOMIC_RELEASE, "agent");
            asm volatile("s_waitcnt vmcnt(0)" ::: "memory");
            const unsigned og = xb_add(&bar[XB_TOP], 1u);
            const unsigned tg = og / nx;
            if (og + 1u == (tg + 1u) * nx) xb_add(&bar[XB_TOPGEN], 1u);
            else XB_SPIN(xb_ld(&bar[XB_TOPGEN]) == tg, bar);
            __builtin_amdgcn_fence(__ATOMIC_ACQUIRE, "agent");
            xb_add(&bar[XB_XGEN(b.x)], 1u);
            asm volatile("s_waitcnt vmcnt(0)" ::: "memory");
        } else {
            XB_SPIN(xb_ld(&bar[XB_XGEN(b.x)]) == gen, bar);
            __builtin_amdgcn_fence(__ATOMIC_ACQUIRE, "agent");
            asm volatile("s_waitcnt vmcnt(0)" ::: "memory");
        }
    }
    __syncthreads();
}


struct Frame {
    LAS unsigned char* lds;
    volatile LAS unsigned* MISC;
    gu32* ctl;
    int tid, lane, wave, G, bid, lo, hi;
    const float *x, *w_in, *w_out, *mu, *w0, *w_up, *a0, *a_up, *g_up, *k_k, *k_a, *r_k, *rln_g, *rln_b, *gn_g, *gn_b, *rel_bias, *ln_g, *ln_b;
    const float *ffn_g, *ffn_u, *ffn_d, *router, *moe_g, *moe_u, *moe_d;
    float* out;
    float* TAB;
    bf16 *WIN_T, *WOUT_T, *WGU_T, *WD_T, *WGUE, *WDE, *XB, *P, *Y, *HID, *XG;
    float *SCR, *H;
    unsigned char* TOK;
};

__device__ __forceinline__ void transpose_item(const float* W, int K, int N, bf16* WT, LAS float* scr, int item, int lane, int mode) {
    const int nblk = N / 32, kb = item / nblk, nb = item % nblk, k0 = 64 * kb, n0 = 32 * nb;
#pragma unroll 8
    for (int i = 0; i < 32; ++i) { const int kk = 2 * i + (lane >> 5); scr[kk * 33 + (lane & 31)] = W[(size_t)(k0 + kk) * N + n0 + (lane & 31)]; }
    LDS_WAIT(); asm volatile("" ::: "memory");
    const int drow0 = (mode == 0) ? n0 : ((n0 >> 7) * 256 + (n0 & 127) + (mode == 2 ? 128 : 0));
    const int c = lane & 7;
#pragma unroll
    for (int j = 0; j < 4; ++j) { const int n = (lane >> 3) + 8 * j; const LAS float* s = scr + (8 * c) * 33 + n;
        v4u o; o.x = pk2(s[0 * 33], s[1 * 33]); o.y = pk2(s[2 * 33], s[3 * 33]); o.z = pk2(s[4 * 33], s[5 * 33]); o.w = pk2(s[6 * 33], s[7 * 33]);
        *(GAS v4u*)(WT + (size_t)(drow0 + n) * K + k0 + 8 * c) = o; }
    LDS_WAIT(); asm volatile("" ::: "memory");
}
__device__ __forceinline__ void convert_moe(Frame& F, int j) {
    LAS float* scr = (LAS float*)(F.lds + F.wave * 16384);
    const int gw = F.bid * NWAVES + F.wave, NGW = F.G * NWAVES;
    constexpr int I_E = 1792, PER_E = 3 * I_E, NIT = NE * PER_E;
    for (int it = gw; it < NIT; it += NGW) {
        const int e = it / PER_E; int r = it - e * PER_E;
        const size_t eo = (size_t)(j * NE + e) * D * FFE;
        if (r < I_E) transpose_item(F.moe_g + eo, D, FFE, F.WGUE + (size_t)e * 2 * FFE * D, scr, r, F.lane, 1);
        else if (r < 2 * I_E) transpose_item(F.moe_u + eo, D, FFE, F.WGUE + (size_t)e * 2 * FFE * D, scr, r - I_E, F.lane, 2);
        else transpose_item(F.moe_d + eo, FFE, D, F.WDE + (size_t)e * D * FFE, scr, r - 2 * I_E, F.lane, 0);
    }
}
__device__ __forceinline__ void sincos_pos(double x, float& s, float& c) {
    const double kd = __builtin_rint(x * 0.63661977236758134308);
    const double r = (x - kd * 1.57079632679489655800e+00) - kd * 6.12323399573676603587e-17;
    const int k = (int)kd & 3; const double r2 = r * r;
    const double sp = r * (1.0 + r2 * (-1.0 / 6 + r2 * (1.0 / 120 + r2 * (-1.0 / 5040 + r2 * (1.0 / 362880 + r2 * (-1.0 / 39916800 + r2 * (1.0 / 6227020800.0)))))));
    const double cp = 1.0 + r2 * (-0.5 + r2 * (1.0 / 24 + r2 * (-1.0 / 720 + r2 * (1.0 / 40320 + r2 * (-1.0 / 3628800 + r2 * (1.0 / 479001600 + r2 * (-1.0 / 87178291200.0)))))));
    const double ss = (k == 0) ? sp : (k == 1) ? cp : (k == 2) ? -sp : -cp;
    const double cc = (k == 0) ? cp : (k == 1) ? -sp : (k == 2) ? -cp : sp;
    s = (float)ss; c = (float)cc;
}
__device__ __forceinline__ void ph_prologue(Frame& F) {
    LAS float* scr = (LAS float*)(F.lds + F.wave * 16384);
    const int gw = F.bid * NWAVES + F.wave, NGW = F.G * NWAVES;
    constexpr int I_IN = 16 * 112, I_OUT = 16 * 32, I_GU = 16 * 88, I_DN = 44 * 32;
    constexpr int PER_L = I_IN + I_OUT, PER_J = 2 * I_GU + I_DN, N1 = 4 * PER_L + 2 * PER_J;
    for (int it = gw; it < N1; it += NGW) {
        int r = it;
        if (r < 4 * PER_L) { const int l = r / PER_L; r -= l * PER_L;
            if (r < I_IN) transpose_item(F.w_in + (size_t)l * D * NIN, D, NIN, F.WIN_T + (size_t)l * NIN * D, scr, r, F.lane, 0);
            else transpose_item(F.w_out + (size_t)l * D * D, D, D, F.WOUT_T + (size_t)l * D * D, scr, r - I_IN, F.lane, 0);
        } else { r -= 4 * PER_L; const int j = r / PER_J; r -= j * PER_J;
            if (r < I_GU) transpose_item(F.ffn_g + (size_t)j * D * FFD, D, FFD, F.WGU_T + (size_t)j * 2 * FFD * D, scr, r, F.lane, 1);
            else if (r < 2 * I_GU) transpose_item(F.ffn_u + (size_t)j * D * FFD, D, FFD, F.WGU_T + (size_t)j * 2 * FFD * D, scr, r - I_GU, F.lane, 2);
            else transpose_item(F.ffn_d + (size_t)j * FFD * D, FFD, D, F.WD_T + (size_t)j * D * FFD, scr, r - 2 * I_GU, F.lane, 0);
        }
    }
    convert_moe(F, 0);
    { const size_t n8 = (size_t)T * D / 8;
      for (size_t i = (size_t)F.bid * NTHR + F.tid; i < n8; i += (size_t)F.G * NTHR) {
          const f32x4 a = ((const GAS f32x4*)F.x)[2 * i], b = ((const GAS f32x4*)F.x)[2 * i + 1];
          v4u o; o.x = pk2(a.x, a.y); o.y = pk2(a.z, a.w); o.z = pk2(b.x, b.y); o.w = pk2(b.z, b.w);
          ((GAS v4u*)F.XB)[i] = o; } }
    const int gt = F.bid * NTHR + F.tid;
    if (gt < 3 * 8 * 129) {
        const int p = gt / 1032, h = (gt / 129) % 8, rel = gt % 129, dist = rel * (p == 0 ? 1 : (p == 1 ? 4 : 16));
        int b = dist;
        if (dist >= 16) { b = 16; b += dist >= 22; b += dist >= 30; b += dist >= 40; b += dist >= 54; b += dist >= 73; b += dist >= 99; b += dist >= 134; b += dist >= 182;
            b += dist >= 246; b += dist >= 332; b += dist >= 450; b += dist >= 609; b += dist >= 825; b += dist >= 1117; b += dist >= 1513; }
        F.TAB[TAB_BIAS + gt] = F.rel_bias[b * 8 + h];
    }
    for (int i = gt; i < SEQ * 32; i += F.G * NTHR) {
        const int pos = i >> 5, k = i & 31; double invd = 1.0;
        for (int q = 0; q < k; ++q) invd *= 0.7498942093324559;
        const float inv = (float)invd, ang = (float)pos * inv; float s, c; sincos_pos((double)ang, s, c);
        F.TAB[TAB_COS + i] = c; F.TAB[TAB_SIN + i] = s;
    }
}

__device__ __forceinline__ void ph_rwkv_prep(Frame& F, int l) {
    LAS float* Tl = (LAS float*)F.lds;
    const float* mu = F.mu + l * 1024;
    const size_t AS = (size_t)T * 256;
    for (int tile = F.bid; tile < T / 16; tile += F.G) {
        const int t0 = tile * 16;
        { const int c0 = 2 * F.tid; const float mu0 = mu[c0], mu1 = mu[c0 + 1];
          float p0 = 0.f, p1 = 0.f;
          if ((t0 & (SEQ - 1)) != 0) { const unsigned u = *(const GAS unsigned*)(F.P + (size_t)(t0 - 1) * NIN + c0); p0 = bflo(u); p1 = bfhi(u); }
#pragma unroll 4
          for (int i = 0; i < 16; ++i) { const unsigned u = *(const GAS unsigned*)(F.P + (size_t)(t0 + i) * NIN + c0); const float v0 = bflo(u), v1 = bfhi(u);
              float s0 = v0 + (p0 - v0) * mu0, s1 = v1 + (p1 - v1) * mu1; p0 = v0; p1 = v1;
              if (c0 >= 768 && c0 < 832) { s0 = 1.0f - 2.0f / (__expf(2.0f * s0) + 1.0f); s1 = 1.0f - 2.0f / (__expf(2.0f * s1) + 1.0f); }
              else if (c0 >= 896) { s0 = sigm(s0); s1 = sigm(s1); }
              Tl[i * 1024 + c0] = s0; Tl[i * 1024 + c0 + 1] = s1; } }
        __syncthreads();
        const int j = F.tid & 255, hf = F.tid >> 8;
        float aw[8], aa[8], ag[8];
#pragma unroll
        for (int k = 0; k < 8; ++k) { aw[k] = 0.f; aa[k] = 0.f; ag[k] = 0.f; }
        const float* wup = F.w_up + (size_t)l * 64 * 256 + j; const float* aup = F.a_up + (size_t)l * 64 * 256 + j; const float* gup = F.g_up + (size_t)l * 128 * 256 + j;
        const LAS float* Tr = Tl + hf * 8 * 1024;
#pragma unroll 4
        for (int i = 0; i < 64; ++i) { const float wv = wup[i * 256], av = aup[i * 256];
#pragma unroll
            for (int k = 0; k < 8; ++k) { aw[k] += Tr[k * 1024 + 768 + i] * wv; aa[k] += Tr[k * 1024 + 832 + i] * av; } }
#pragma unroll 4
        for (int i = 0; i < 128; ++i) { const float gv = gup[i * 256];
#pragma unroll
            for (int k = 0; k < 8; ++k) ag[k] += Tr[k * 1024 + 896 + i] * gv; }
        const float w0j = F.w0[l * 256 + j], a0j = F.a0[l * 256 + j], kkj = F.k_k[l * 256 + j], kaj = F.k_a[l * 256 + j];
#pragma unroll
        for (int k = 0; k < 8; ++k) { const int tok = t0 + hf * 8 + k;
            const float dec = __expf(-0.6065306597126334f * sigm(w0j + aw[k])), a = sigm(a0j + aa[k]);
            const float r = Tr[k * 1024 + j], kx = Tr[k * 1024 + 256 + j], v = Tr[k * 1024 + 512 + j];
            const float kk = kx * kkj, ss = wave_sum(kk * kk), kap = kk / fmaxf(sqrtf(ss), 1e-12f);
            const float kp = kx * (1.0f + (a - 1.0f) * kaj), bb = kap * a;
            const size_t idx = (size_t)tok * 256 + j;
            F.SCR[idx] = r; F.SCR[AS + idx] = dec; F.SCR[2 * AS + idx] = kp; F.SCR[3 * AS + idx] = kap; F.SCR[4 * AS + idx] = bb; F.SCR[5 * AS + idx] = v; F.SCR[6 * AS + idx] = ag[k]; }
        __syncthreads();
    }
}
__device__ __forceinline__ void ph_attn_naive(Frame& F) {
    for (int grp = F.bid; grp < T / 64; grp += F.G) {
        const int t = grp * 64 + F.lane, h = F.wave, ts = t & (SEQ - 1);
        float q[64], acc[64];
        { const GAS v4u* qp = (const GAS v4u*)(F.P + (size_t)t * NIN + C_AQ + h * 64);
#pragma unroll
          for (int i = 0; i < 8; ++i) { const v4u u = qp[i]; q[8 * i] = bflo(u.x); q[8 * i + 1] = bfhi(u.x); q[8 * i + 2] = bflo(u.y); q[8 * i + 3] = bfhi(u.y); q[8 * i + 4] = bflo(u.z); q[8 * i + 5] = bfhi(u.z); q[8 * i + 6] = bflo(u.w); q[8 * i + 7] = bfhi(u.w); } }
#pragma unroll
        for (int e = 0; e < 64; ++e) acc[e] = 0.f;
        float m = -1e30f, ls = 0.f;
        for (int p = 0; p < 3; ++p) {
            const int dil = (p == 0) ? 1 : ((p == 1) ? 4 : 16);
            const float* bt = F.TAB + TAB_BIAS + (p * 8 + h) * 129;
            for (int rel = 0; rel <= 128; ++rel) {
                const int tt = ts - rel * dil;
                if (tt >= 0) {
                    const GAS v4u* kp = (const GAS v4u*)(F.P + (size_t)(t - rel * dil) * NIN + C_AK + h * 64);
                    const GAS v4u* vp = (const GAS v4u*)(F.P + (size_t)(t - rel * dil) * NIN + C_AV + h * 64);
                    float s = 0.f;
#pragma unroll
                    for (int i = 0; i < 8; ++i) { const v4u u = kp[i];
                        s += q[8 * i] * bflo(u.x) + q[8 * i + 1] * bfhi(u.x) + q[8 * i + 2] * bflo(u.y) + q[8 * i + 3] * bfhi(u.y) + q[8 * i + 4] * bflo(u.z) + q[8 * i + 5] * bfhi(u.z) + q[8 * i + 6] * bflo(u.w) + q[8 * i + 7] * bfhi(u.w); }
                    s = s * 0.125f + bt[rel];
                    const float mn = fmaxf(m, s), corr = __expf(m - mn), pr = __expf(s - mn);
                    ls = ls * corr + pr; m = mn;
#pragma unroll
                    for (int i = 0; i < 8; ++i) { const v4u u = vp[i];
                        acc[8 * i] = acc[8 * i] * corr + pr * bflo(u.x); acc[8 * i + 1] = acc[8 * i + 1] * corr + pr * bfhi(u.x);
                        acc[8 * i + 2] = acc[8 * i + 2] * corr + pr * bflo(u.y); acc[8 * i + 3] = acc[8 * i + 3] * corr + pr * bfhi(u.y);
                        acc[8 * i + 4] = acc[8 * i + 4] * corr + pr * bflo(u.z); acc[8 * i + 5] = acc[8 * i + 5] * corr + pr * bfhi(u.z);
                        acc[8 * i + 6] = acc[8 * i + 6] * corr + pr * bflo(u.w); acc[8 * i + 7] = acc[8 * i + 7] * corr + pr * bfhi(u.w); }
                }
            }
        }
        const float il = 1.0f / ls;
        GAS v4u* op = (GAS v4u*)(F.Y + (size_t)t * D + 256 + h * 64);
#pragma unroll
        for (int i = 0; i < 8; ++i) { v4u o; o.x = pk2(acc[8 * i] * il, acc[8 * i + 1] * il); o.y = pk2(acc[8 * i + 2] * il, acc[8 * i + 3] * il); o.z = pk2(acc[8 * i + 4] * il, acc[8 * i + 5] * il); o.w = pk2(acc[8 * i + 6] * il, acc[8 * i + 7] * il); op[i] = o; }
    }
}

__device__ __forceinline__ void ph_scans_naive(Frame& F, int l) {
    if (F.wave != 0) return;
    const size_t AS = (size_t)T * 256;
    for (int u = F.bid; u < 64; u += F.G) {
        if (u < 32) {
            const int b = u >> 2, h = u & 3; const int ch = h * 64 + F.lane;
            const float lng = F.rln_g[l * 256 + ch], lnb = F.rln_b[l * 256 + ch], rk = F.r_k[l * 256 + ch];
            float S[64];
#pragma unroll
            for (int c = 0; c < 64; ++c) S[c] = 0.f;
            size_t idx = (size_t)b * SEQ * 256 + ch;
            float rc = F.SCR[idx], wc = F.SCR[AS + idx], kc = F.SCR[2 * AS + idx], kapc = F.SCR[3 * AS + idx], bc = F.SCR[4 * AS + idx], vi = F.SCR[5 * AS + idx], gi = F.SCR[6 * AS + idx];
            for (int t = 0; t < SEQ; ++t) {
                const size_t nidx = (t + 1 < SEQ) ? idx + 256 : idx;
                const float rn = F.SCR[nidx], wn = F.SCR[AS + nidx], kn = F.SCR[2 * AS + nidx], kapn = F.SCR[3 * AS + nidx], bn = F.SCR[4 * AS + nidx], vn = F.SCR[5 * AS + nidx], gn = F.SCR[6 * AS + nidx];
                float sa = 0.f;
#pragma unroll
                for (int c = 0; c < 64; ++c) sa += S[c] * rdl(kapc, c);
                sa = -sa;
                float y = 0.f;
#pragma unroll
                for (int c = 0; c < 64; ++c) { S[c] = S[c] * rdl(wc, c) + sa * rdl(bc, c) + vi * rdl(kc, c); y += S[c] * rdl(rc, c); }
                const float mean = wave_sum(y) * (1.0f / 64.0f), dd = y - mean, var = wave_sum(dd * dd) * (1.0f / 64.0f);
                const float yn = dd * (1.0f / sqrtf(var + 64e-5f)) * lng + lnb;
                const float bonus = wave_sum(rc * kc * rk) * vi;
                F.Y[(size_t)(b * SEQ + t) * D + ch] = (bf16)f2bf((yn + bonus) * gi);
                rc = rn; wc = wn; kc = kn; kapc = kapn; bc = bn; vi = vn; gi = gn; idx = nidx;
            }
        } else {
            const int uu = u - 32, b = uu >> 2, h = uu & 3; const int ch = h * 64 + F.lane;
            const float gg = F.gn_g[l * 256 + ch], gb = F.gn_b[l * 256 + ch];
            const float gamma = 1.0f - exp2f(-5.0f - (float)h);
            float S[64];
#pragma unroll
            for (int d = 0; d < 64; ++d) S[d] = 0.f;
            const int fi = F.lane & 31;
            const bf16* pp = F.P + (size_t)b * SEQ * NIN + ch;
            float qn = bf2f(pp[C_RQ]), kn = bf2f(pp[C_RK]), vn = bf2f(pp[C_RV]), gn = bf2f(pp[C_RG]);
            for (int t = 0; t < SEQ; ++t) {
                const float qc = qn, kc = kn, ve = vn, ge = gn;
                if (t + 1 < SEQ) { const bf16* pn = pp + (size_t)(t + 1) * NIN; qn = bf2f(pn[C_RQ]); kn = bf2f(pn[C_RK]); vn = bf2f(pn[C_RV]); gn = bf2f(pn[C_RG]); }
                const float cs = F.TAB[TAB_COS + t * 32 + fi], sn = F.TAB[TAB_SIN + t * 32 + fi];
                const float qo = __shfl_xor(qc, 32), ko = __shfl_xor(kc, 32);
                const float qr = (F.lane < 32) ? (qc * cs - qo * sn) : (qo * sn + qc * cs);
                const float kr = ((F.lane < 32) ? (kc * cs - ko * sn) : (ko * sn + kc * cs)) * 0.125f;
                float y = 0.f;
#pragma unroll
                for (int d = 0; d < 64; ++d) { S[d] = gamma * S[d] + rdl(kr, d) * ve; y += rdl(qr, d) * S[d]; }
                const float mean = wave_sum(y) * (1.0f / 64.0f), dd = y - mean, var = wave_sum(dd * dd) * (1.0f / 64.0f);
                const float yn = dd * (1.0f / sqrtf(var + LN_EPS)) * gg + gb;
                F.Y[(size_t)(b * SEQ + t) * D + 768 + ch] = (bf16)f2bf(ge * sigm(ge) * yn);
            }
        }
    }
}

template <int MODE>
__device__ __forceinline__ void ph_ln(Frame& F, const float* xres, const float* lg, const float* lb, const float* router) {
    f32x4 gv[4], bv[4];
#pragma unroll
    for (int j = 0; j < 4; ++j) { gv[j] = ((const GAS f32x4*)lg)[64 * j + F.lane]; bv[j] = ((const GAS f32x4*)lb)[64 * j + F.lane]; }
    GAS v4i* TI = (GAS v4i*)(F.TOK + TOK_TI); GAS f32x2* TG = (GAS f32x2*)(F.TOK + TOK_TG); GAS v2i* TP = (GAS v2i*)(F.TOK + TOK_TP); GAS int* CW = (GAS int*)(F.TOK + TOK_CW);
    for (int c = F.bid; c < T / 128; c += F.G) {
        int cnt[8];
#pragma unroll
        for (int e = 0; e < 8; ++e) cnt[e] = 0;
        for (int i = 0; i < 16; ++i) {
            const int t = c * 128 + F.wave * 16 + i;
            const GAS f32x4* xr = (const GAS f32x4*)(xres + (size_t)t * D) + F.lane;
            f32x4 v[4];
            if (MODE == 2) {
                const v2i tp = TP[t]; const f32x2 tg = TG[t];
                const GAS v2u* y0 = (const GAS v2u*)(F.XG + (size_t)tp.x * D) + F.lane; const GAS v2u* y1 = (const GAS v2u*)(F.XG + (size_t)tp.y * D) + F.lane;
#pragma unroll
                for (int j = 0; j < 4; ++j) { const v2u a = y0[64 * j], b = y1[64 * j]; const f32x4 xx = xr[64 * j];
                    v[j].x = ALPHA * xx.x + tg.x * bflo(a.x) + tg.y * bflo(b.x); v[j].y = ALPHA * xx.y + tg.x * bfhi(a.x) + tg.y * bfhi(b.x);
                    v[j].z = ALPHA * xx.z + tg.x * bflo(a.y) + tg.y * bflo(b.y); v[j].w = ALPHA * xx.w + tg.x * bfhi(a.y) + tg.y * bfhi(b.y); }
            } else {
                const GAS f32x4* hr = (const GAS f32x4*)(F.H + (size_t)t * D) + F.lane;
#pragma unroll
                for (int j = 0; j < 4; ++j) v[j] = ALPHA * xr[64 * j] + hr[64 * j];
            }
            float s = 0.f;
#pragma unroll
            for (int j = 0; j < 4; ++j) s += (v[j].x + v[j].y) + (v[j].z + v[j].w);
            const float mean = wave_sum(s) * (1.f / D); float s2 = 0.f;
#pragma unroll
            for (int j = 0; j < 4; ++j) { v[j] = v[j] - mean; s2 += (v[j].x * v[j].x + v[j].y * v[j].y) + (v[j].z * v[j].z + v[j].w * v[j].w); }
            const float rstd = 1.f / sqrtf(wave_sum(s2) * (1.f / D) + LN_EPS);
            GAS f32x4* orow = (GAS f32x4*)(F.out + (size_t)t * D) + F.lane; GAS v2u* brow = (GAS v2u*)(F.XB + (size_t)t * D) + F.lane;
#pragma unroll
            for (int j = 0; j < 4; ++j) { v[j] = v[j] * rstd * gv[j] + bv[j]; orow[64 * j] = v[j]; v2u o; o.x = pk2(v[j].x, v[j].y); o.y = pk2(v[j].z, v[j].w); brow[64 * j] = o; }
            if (MODE == 1) {
                float lg8[8];
#pragma unroll
                for (int e = 0; e < 8; ++e) lg8[e] = 0.f;
#pragma unroll
                for (int j = 0; j < 4; ++j) { const GAS f32x4* rr = (const GAS f32x4*)(router + (size_t)(256 * j + 4 * F.lane) * 8);
#pragma unroll
                    for (int k = 0; k < 4; ++k) { const f32x4 r0 = rr[2 * k], r1 = rr[2 * k + 1]; const float xv = v[j][k];
                        lg8[0] += xv * r0.x; lg8[1] += xv * r0.y; lg8[2] += xv * r0.z; lg8[3] += xv * r0.w; lg8[4] += xv * r1.x; lg8[5] += xv * r1.y; lg8[6] += xv * r1.z; lg8[7] += xv * r1.w; } }
#pragma unroll
                for (int e = 0; e < 8; ++e) lg8[e] = wave_sum(lg8[e]);
                int e0 = 0; float l0 = lg8[0];
#pragma unroll
                for (int e = 1; e < 8; ++e) if (lg8[e] > l0) { l0 = lg8[e]; e0 = e; }
                int e1 = -1; float l1 = -3.0e38f;
#pragma unroll
                for (int e = 0; e < 8; ++e) if (e != e0 && lg8[e] > l1) { l1 = lg8[e]; e1 = e; }
                const float g0 = 1.0f / (1.0f + __expf(l1 - l0)), g1 = 1.0f - g0;
                int p0 = 0, p1 = 0;
#pragma unroll
                for (int e = 0; e < 8; ++e) { if (e == e0) { p0 = cnt[e]; cnt[e] += 1; } if (e == e1) { p1 = cnt[e]; cnt[e] += 1; } }
                if (F.lane == 0) { TI[t] = (v4i){e0, e1, p0, p1}; TG[t] = (f32x2){g0, g1}; }
            }
        }
        if (MODE == 1 && F.lane == 0) {
#pragma unroll
            for (int e = 0; e < 8; ++e) CW[(c * 8 + F.wave) * 8 + e] = cnt[e];
        }
    }
}

__device__ __forceinline__ void ph_moe_gather(Frame& F) {
    LAS int* PS = (LAS int*)F.lds;
    LAS int* TOTL = PS + 512 * 8;
    GAS v4i* TI = (GAS v4i*)(F.TOK + TOK_TI); GAS v2i* TP = (GAS v2i*)(F.TOK + TOK_TP); GAS int* CW = (GAS int*)(F.TOK + TOK_CW);
    { int s[8];
#pragma unroll
      for (int e = 0; e < 8; ++e) s[e] = 0;
      for (int q = 0; q < 4; ++q) {
#pragma unroll
          for (int e = 0; e < 8; ++e) s[e] += CW[(F.tid * 4 + q) * 8 + e]; }
#pragma unroll
      for (int e = 0; e < 8; ++e) PS[F.tid * 8 + e] = s[e]; }
    __syncthreads();
    if (F.tid < 8) { int run = 0; for (int i = 0; i < 512; ++i) { const int v = PS[i * 8 + F.tid]; PS[i * 8 + F.tid] = run; run += v; } TOTL[F.tid] = run; }
    __syncthreads();
    if (F.tid == 0) { int ps = 0; for (int e = 0; e < 8; ++e) { const int pad = (TOTL[e] + 255) / 256 * 256; TOTL[8 + e] = ps; ps += pad; TOTL[16 + e] = ps; } }
    __syncthreads();
    if (F.bid == 0 && F.tid < 8) ((GAS int*)(F.TAB + TAB_META))[F.tid] = TOTL[16 + F.tid];
    for (int c = F.bid; c < T / 128; c += F.G) {
        int base[8];
#pragma unroll
        for (int e = 0; e < 8; ++e) { int b = TOTL[8 + e] + PS[(2 * c) * 8 + e];
            for (int w = 0; w < F.wave; ++w) b += CW[(c * 8 + w) * 8 + e];
            base[e] = b; }
        for (int i = 0; i < 16; ++i) {
            const int t = c * 128 + F.wave * 16 + i; const v4i ti = TI[t];
            int pos0 = ti.z, pos1 = ti.w;
#pragma unroll
            for (int e = 0; e < 8; ++e) { if (e == ti.x) pos0 += base[e]; if (e == ti.y) pos1 += base[e]; }
            const GAS v4u* src = (const GAS v4u*)(F.XB + (size_t)t * D) + F.lane;
            GAS v4u* d0 = (GAS v4u*)(F.XG + (size_t)pos0 * D) + F.lane; GAS v4u* d1 = (GAS v4u*)(F.XG + (size_t)pos1 * D) + F.lane;
            const v4u a = src[0], b = src[64]; d0[0] = a; d0[64] = b; d1[0] = a; d1[64] = b;
            if (F.lane == 0) TP[t] = (v2i){pos0, pos1};
        }
    }
    for (int i = F.bid * NWAVES + F.wave; i < NE * 256; i += F.G * NWAVES) {
        const int e = i >> 8, row = TOTL[8 + e] + TOTL[e] + (i & 255);
        if (row < TOTL[16 + e]) { GAS v4u* d = (GAS v4u*)(F.XG + (size_t)row * D) + F.lane; d[0] = (v4u){0u, 0u, 0u, 0u}; d[64] = (v4u){0u, 0u, 0u, 0u}; }
    }
}

struct Args { const float* in[26]; float* out; unsigned char* ws; int ph_lo, ph_hi; };
constexpr int N_PHASES = 1 + 2 * 8 + 2 * 11;

typedef const __attribute__((address_space(4))) Args* KArgs;
__device__ __forceinline__ void mk_frame(Frame& F, LAS unsigned char* lds) {
    KArgs ka = (KArgs)__builtin_amdgcn_kernarg_segment_ptr(); asm volatile("" : "+s"(ka));
    F.lds = lds; F.MISC = (volatile LAS unsigned*)(lds + MISC_OFF);
    { int t_ = threadIdx.x; asm volatile("" : "+v"(t_)); F.tid = t_; }
    { int b_ = blockIdx.x; asm volatile("" : "+s"(b_)); F.bid = b_; }
    F.lane = F.tid & 63; F.wave = __builtin_amdgcn_readfirstlane(F.tid >> 6); F.G = gridDim.x;
    F.lo = ka->ph_lo; F.hi = ka->ph_hi;
    unsigned char* ws = ka->ws;
    F.ctl = (gu32*)(ws + WS_CTL);
    F.x = ka->in[0]; F.w_in = ka->in[1]; F.w_out = ka->in[2]; F.mu = ka->in[3]; F.w0 = ka->in[4]; F.w_up = ka->in[5]; F.a0 = ka->in[6]; F.a_up = ka->in[7]; F.g_up = ka->in[8];
    F.k_k = ka->in[9]; F.k_a = ka->in[10]; F.r_k = ka->in[11]; F.rln_g = ka->in[12]; F.rln_b = ka->in[13]; F.gn_g = ka->in[14]; F.gn_b = ka->in[15]; F.rel_bias = ka->in[16];
    F.ln_g = ka->in[17]; F.ln_b = ka->in[18]; F.ffn_g = ka->in[19]; F.ffn_u = ka->in[20]; F.ffn_d = ka->in[21]; F.router = ka->in[22]; F.moe_g = ka->in[23]; F.moe_u = ka->in[24]; F.moe_d = ka->in[25];
    F.out = ka->out;
    F.TAB = (float*)(ws + WS_TAB);
    F.WIN_T = (bf16*)(ws + WS_WIN); F.WOUT_T = (bf16*)(ws + WS_WOUT); F.WGU_T = (bf16*)(ws + WS_WGU); F.WD_T = (bf16*)(ws + WS_WD); F.WGUE = (bf16*)(ws + WS_WGUE); F.WDE = (bf16*)(ws + WS_WDE);
    F.XB = (bf16*)(ws + WS_XB); F.P = (bf16*)(ws + WS_SH + SH_P); F.Y = (bf16*)(ws + WS_SH + SH_Y); F.SCR = (float*)(ws + WS_SH + SH_SCR);
    F.H = (float*)(ws + WS_SH + SH_H); F.HID = (bf16*)(ws + WS_SH + SH_HID); F.XG = (bf16*)(ws + WS_SH + SH_XG); F.TOK = ws + WS_SH + SH_TOK;
}

__global__ void __launch_bounds__(NTHR, 2) fwd_kernel(Args args) {
    extern __shared__ __attribute__((aligned(16))) unsigned char lds[];
    const int tid0 = threadIdx.x;
    for (int u = tid0; u < (LDS_BYTES - LDSCTL_OFF) / 4; u += NTHR) ((LAS unsigned*)((LAS unsigned char*)lds + LDSCTL_OFF))[u] = 0u;
    __syncthreads();
    unsigned* const barw = (unsigned*)(args.ws + WS_CTL) + CW_BAR;
    XcdBarrier bar; bar.bar = barw; bar.x = 0; bar.st = nullptr;
    if (args.ph_hi - args.ph_lo > 1) bar = xcd_barrier_post(barw, (volatile LAS unsigned*)((LAS unsigned char*)lds + MISC_OFF) + 8);
#define PH_BEGIN(phx) { Frame F; mk_frame(F, (LAS unsigned char*)lds); const int ph = (phx); if (ph >= F.lo && ph < F.hi) {
#define PH_END   if (ph + 1 < F.hi) xcd_barrier(bar); } }

    PH_BEGIN(0) ph_prologue(F); PH_END

    for (int l = 0; l < DEPTH; ++l) {
        const int jj = l >> 1; const bool moe = (l & 1) != 0; const int pb = 1 + jj * 19 + (l & 1) * 8;
        PH_BEGIN(pb + 0)
            pg8::Gemm g{F.XB, F.WIN_T + (size_t)l * NIN * D, T, NIN, D}; pg8::StaticOrder S; S.init(T, NIN, F.G, F.bid);
            pg8::EpiBf16<0> E{F.P, NIN, nullptr, 0, 0, 1.f};
            pg8::gemm_phase<pg8::EpiBf16<0>, pg8::StaticOrder, true, true>(F.lds + RING_OFF, g, S, E);
        PH_END
        PH_BEGIN(pb + 1)
            if (l == 3) { convert_moe(F, 1); __syncthreads(); }
            ph_rwkv_prep(F, l);
            ph_attn_naive(F);
        PH_END
        PH_BEGIN(pb + 2) ph_scans_naive(F, l); PH_END
        PH_BEGIN(pb + 3)
            pg8::Gemm g{F.Y, F.WOUT_T + (size_t)l * D * D, T, D, D}; pg8::StaticOrder S; S.init(T, D, F.G, F.bid);
            pg8::EpiF32 E{F.H, D};
            pg8::gemm_phase<pg8::EpiF32, pg8::StaticOrder, true, true>(F.lds + RING_OFF, g, S, E);
        PH_END
        PH_BEGIN(pb + 4)
            const float* xres = (l == 0) ? F.x : F.out;
            if (moe) ph_ln<1>(F, xres, F.ln_g + (size_t)(l * 2) * D, F.ln_b + (size_t)(l * 2) * D, F.router + (size_t)jj * D * NE);
            else ph_ln<0>(F, xres, F.ln_g + (size_t)(l * 2) * D, F.ln_b + (size_t)(l * 2) * D, nullptr);
        PH_END
        if (!moe) {
            PH_BEGIN(pb + 5)
                pg8::Gemm g{F.XB, F.WGU_T + (size_t)jj * 2 * FFD * D, T, 2 * FFD, D}; pg8::StaticOrder S; S.init(T, 2 * FFD, F.G, F.bid);
                pg8::EpiSwiglu E{F.HID, FFD};
                pg8::gemm_phase<pg8::EpiSwiglu, pg8::StaticOrder, true, true>(F.lds + RING_OFF, g, S, E);
            PH_END
            PH_BEGIN(pb + 6)
                pg8::Gemm g{F.HID, F.WD_T + (size_t)jj * D * FFD, T, D, FFD}; pg8::StaticOrder S; S.init(T, D, F.G, F.bid);
                pg8::EpiF32 E{F.H, D};
                pg8::gemm_phase<pg8::EpiF32, pg8::StaticOrder, true, true>(F.lds + RING_OFF, g, S, E);
            PH_END
            PH_BEGIN(pb + 7) ph_ln<0>(F, F.out, F.ln_g + (size_t)(l * 2 + 1) * D, F.ln_b + (size_t)(l * 2 + 1) * D, nullptr); PH_END
        } else {
            PH_BEGIN(pb + 5) ph_moe_gather(F); PH_END
            for (int half = 0; half < 2; ++half) {
                PH_BEGIN(pb + 6 + 2 * half)
                    const GAS int* meta = (const GAS int*)(F.TAB + TAB_META);
                    pg8::MoeOrder S;
#pragma unroll
                    for (int e = 0; e < 8; ++e) S.pend[e] = __builtin_amdgcn_readfirstlane(meta[e]);
                    const int nblk = S.pend[7] / 256, nb0 = (nblk + 1) / 2; const int pm_off = half ? nb0 : 0, nbh = half ? (nblk - nb0) : nb0;
                    S.pm_off = pm_off; S.estride = (size_t)2 * FFE * D * 2; S.init(nbh * 256, 2 * FFE, F.G, F.bid);
                    pg8::Gemm g{F.XG + (size_t)pm_off * 256 * D, F.WGUE, nbh * 256, 2 * FFE, D};
                    pg8::EpiSwiglu E{F.HID, FFE};
                    pg8::gemm_phase<pg8::EpiSwiglu, pg8::MoeOrder, true, true>(F.lds + RING_OFF, g, S, E);
                PH_END
                PH_BEGIN(pb + 7 + 2 * half)
                    const GAS int* meta = (const GAS int*)(F.TAB + TAB_META);
                    pg8::MoeOrder S;
#pragma unroll
                    for (int e = 0; e < 8; ++e) S.pend[e] = __builtin_amdgcn_readfirstlane(meta[e]);
                    const int nblk = S.pend[7] / 256, nb0 = (nblk + 1) / 2; const int pm_off = half ? nb0 : 0, nbh = half ? (nblk - nb0) : nb0;
                    S.pm_off = pm_off; S.estride = (size_t)D * FFE * 2; S.init(nbh * 256, D, F.G, F.bid);
                    pg8::Gemm g{F.HID, F.WDE, nbh * 256, D, FFE};
                    pg8::EpiBf16<0> E{F.XG + (size_t)pm_off * 256 * D, D, nullptr, 0, 0, 1.f};
                    pg8::gemm_phase<pg8::EpiBf16<0>, pg8::MoeOrder, true, true>(F.lds + RING_OFF, g, S, E);
                PH_END
            }
            PH_BEGIN(pb + 10) ph_ln<2>(F, F.out, F.ln_g + (size_t)(l * 2 + 1) * D, F.ln_b + (size_t)(l * 2 + 1) * D, nullptr); PH_END
        }
    }
#undef PH_BEGIN
#undef PH_END
}

#ifndef MK_ONE_LAUNCH
#define MK_ONE_LAUNCH 0
#endif
extern "C" void kernel_launch(void* const* d_in, const int* in_sizes, int n_in, void* d_out, int out_size, void* d_ws, size_t ws_size, hipStream_t stream) {
    static int grid = 0;
    if (grid == 0) {
        if (n_in != 26 || in_sizes[0] != T * D || out_size != T * D || ws_size < WS_END) { fprintf(stderr, "kernel_launch: unexpected shapes (n_in %d, in0 %d, out %d, ws %zu); nothing launched\n", n_in, n_in > 0 ? in_sizes[0] : -1, out_size, ws_size); grid = -1; return; }
        int dev = 0, cus = 0, per_cu = 0;
        if (hipGetDevice(&dev) != hipSuccess || hipDeviceGetAttribute(&cus, hipDeviceAttributeMultiprocessorCount, dev) != hipSuccess) { grid = -1; return; }
        if (hipFuncSetAttribute((const void*)fwd_kernel, hipFuncAttributeMaxDynamicSharedMemorySize, LDS_BYTES) != hipSuccess) { fprintf(stderr, "kernel_launch: hipFuncSetAttribute failed\n"); grid = -1; return; }
        if (hipOccupancyMaxActiveBlocksPerMultiprocessor(&per_cu, (const void*)fwd_kernel, NTHR, LDS_BYTES) != hipSuccess || per_cu < 1) fprintf(stderr, "kernel_launch: occupancy query reports %d\n", per_cu);
        (void)hipGetLastError();
        grid = cus;
    }
    if (grid < 0) return;
    if (hipMemsetAsync((char*)d_ws + WS_CTL, 0, CTL_ZERO_BYTES, stream) != hipSuccess) return;
    Args a{};
    for (int i = 0; i < 26; ++i) a.in[i] = (const float*)d_in[i];
    a.out = (float*)d_out; a.ws = (unsigned char*)d_ws;
#if MK_ONE_LAUNCH
    a.ph_lo = 0; a.ph_hi = N_PHASES;
    hipLaunchKernelGGL(fwd_kernel, dim3(grid), dim3(NTHR), LDS_BYTES, stream, a);
#else
    for (int p = 0; p < N_PHASES; ++p) { a.ph_lo = p; a.ph_hi = p + 1; hipLaunchKernelGGL(fwd_kernel, dim3(grid), dim3(NTHR), LDS_BYTES, stream, a); }
#endif
}
```

```cpp
#include <hip/hip_runtime.h>
#include <cstdio>
#include <cstdint>
namespace pg8 {
#define PG8_LAS __attribute__((address_space(3)))
typedef unsigned short bf16_t;
typedef short bf16x8 __attribute__((ext_vector_type(8)));
typedef float f32x4 __attribute__((ext_vector_type(4)));
typedef unsigned u32x4 __attribute__((ext_vector_type(4)));
constexpr int BM = 256, BK = 64, HALF = 128, HTB = HALF * BK * 2  , STAGE_BYTES = 8 * HTB, NXCD = 8, WGM = 8;

__host__ __device__ __forceinline__ int lds_byte(int r, int c) { const int st = (r >> 4) * 2 + (c >> 5), rr = r & 15, cc = c & 31, ob = rr * 64 + cc * 2; return st * 1024 + (ob ^ (((ob >> 9) & 1) << 5)); }
__host__ __device__ __forceinline__ void stage_rc(int b, int& R, int& C) { const int st = b / 1024, sb = b % 1024, swz = sb ^ (((sb >> 9) & 1) << 5); R = (st >> 1) * 16 + swz / 64; C = (st & 1) * 32 + (swz % 64) / 2; }
__host__ __device__ __forceinline__ int perm32(int rho) { const int n = rho >> 4, i = rho & 15; return 8 * (i >> 2) + 4 * n + (i & 3); }

struct Unit { int pm, pn, kp; };
struct Gemm { const bf16_t* A; const bf16_t* Bt; int M, N, K; int ld = 0; };

struct StaticOrder {
    int nM, nN, nwg, G, c, wgm;
    __host__ __device__ void init(int M, int N, int G_, int c_, int wgm_ = WGM) { nM = M / BM; nN = N / BM; nwg = nM * nN; G = G_; c = c_; wgm = wgm_; }
    __host__ __device__ bool next(int i, Unit& u) const {
        const long L = (long)i * G + c; if (L >= nwg) return false;
        int wgid = (int)L; { const int q = nwg / NXCD, r = nwg % NXCD, xcd = wgid % NXCD, off = wgid / NXCD; wgid = (xcd < r ? xcd * (q + 1) : r * (q + 1) + (xcd - r) * q) + off; }
        const int nig = wgm * nN, gid = wgid / nig, fm = gid * wgm, gsz = (nM - fm) < wgm ? (nM - fm) : wgm;
        u.pm = fm + ((wgid % nig) % gsz); u.pn = (wgid % nig) / gsz; u.kp = 0; return true;
    }
    __device__ __forceinline__ void a_ready(const Unit&) const {}
    __device__ __forceinline__ void done(const Unit&) const {}
    __device__ __forceinline__ size_t b_base_off(const Unit&) const { return 0; }
    __device__ __forceinline__ size_t a_base_off(const Unit&) const { return 0; }
};

__device__ __forceinline__ unsigned cvt_pk_bf16(float lo, float hi) { unsigned r; asm volatile("v_cvt_pk_bf16_f32 %0, %1, %2" : "=v"(r) : "v"(lo), "v"(hi)); return r; }
typedef float f32x2 __attribute__((ext_vector_type(2)));
__device__ __forceinline__ f32x2 gelu_pk(f32x2 v) {
    const f32x2 av = __builtin_elementwise_abs(v), d = av * 0.2316418882f + 1.0f;
    f32x2 t; t.x = __builtin_amdgcn_rcpf(d.x); t.y = __builtin_amdgcn_rcpf(d.y);
    f32x2 q = t * 0.5307027145f + (-0.7265760135f); q = q * t + 0.7107068705f; q = q * t + (-0.142248368f); q = q * t + 0.127414796f; q = q * t;
    const f32x2 s = (v * v) * (-0.72134752044f);
    f32x2 e; e.x = __builtin_amdgcn_exp2f(s.x); e.y = __builtin_amdgcn_exp2f(s.y);
    const f32x2 m = v * (q * e), r = v - m;
    f32x2 o; o.x = v.x < 0.f ? m.x : r.x; o.y = v.y < 0.f ? m.y : r.y; return o;
}

template <int ACT  > struct EpiBf16 {
    static constexpr bool PERM = true, AFTER_DRAIN = false; static_assert(ACT == 0 || ACT == 1, "EpiBf16: ACT is 0 (none) or 1 (gelu_pk)");
    bf16_t* O; int ldc; const float* bias; int split_cols; size_t split_stride; float scale0;
    __device__ __forceinline__ void operator()(const f32x4 (&acc)[2][2][4][2], const Unit& u, int wr, int wc, int fr, int fq) const {
        const int row0 = u.pm * BM + wr * 64 + fr; int colt = u.pn * BM; bf16_t* base = O;
        float sc = 1.f; if (split_cols) { const int t = colt / split_cols; base += (size_t)t * split_stride; colt -= t * split_cols; if (t == 0) sc = scale0; } else sc = scale0;
        const int col0 = colt + wc * 32 + 8 * fq, bcol0 = u.pn * BM + wc * 32 + 8 * fq;
        f32x4 bv[2][2];
#pragma unroll
        for (int bj = 0; bj < 2; ++bj)
#pragma unroll
            for (int n = 0; n < 2; ++n) bv[bj][n] = bias ? *(const f32x4*)(bias + bcol0 + bj * HALF + 4 * n) : (f32x4){0.f, 0.f, 0.f, 0.f};
#pragma unroll
        for (int ai = 0; ai < 2; ++ai)
#pragma unroll
            for (int m = 0; m < 4; ++m) { bf16_t* rowp = base + (size_t)(row0 + ai * HALF + m * 16) * ldc + col0;
#pragma unroll
                for (int bj = 0; bj < 2; ++bj) { f32x4 v0 = acc[ai][bj][m][0] + bv[bj][0], v1 = acc[ai][bj][m][1] + bv[bj][1];
                    if (ACT == 1) { f32x2 a = gelu_pk((f32x2){v0[0], v0[1]}), b = gelu_pk((f32x2){v0[2], v0[3]}), c = gelu_pk((f32x2){v1[0], v1[1]}), d = gelu_pk((f32x2){v1[2], v1[3]});
                        v0 = (f32x4){a.x, a.y, b.x, b.y}; v1 = (f32x4){c.x, c.y, d.x, d.y}; }
                    v0 = v0 * sc; v1 = v1 * sc; u32x4 w; w.x = cvt_pk_bf16(v0[0], v0[1]); w.y = cvt_pk_bf16(v0[2], v0[3]); w.z = cvt_pk_bf16(v1[0], v1[1]); w.w = cvt_pk_bf16(v1[2], v1[3]);
                    *(u32x4*)(rowp + bj * HALF) = w; } }
    }
};

struct PanelStats {
    unsigned* xbuf;
    unsigned* cnt;
    unsigned* tmo;
    int ntn; float eps;
    unsigned code;
    __device__ __forceinline__ bool run(const f32x4 (&v)[2][2][4][2], const Unit& u, int wr, int wc, int fr, int fq, PG8_LAS unsigned char* lds, int wid, int lane) const {
        typedef float f32x2v __attribute__((ext_vector_type(2)));
        PG8_LAS f32x2v* P = (PG8_LAS f32x2v*)lds;
        PG8_LAS f32x2v* S = (PG8_LAS f32x2v*)(lds + 8192);
        PG8_LAS unsigned* flag = (PG8_LAS unsigned*)(lds + 8192 + 2048);
#pragma unroll
        for (int ai = 0; ai < 2; ++ai)
#pragma unroll
            for (int m = 0; m < 4; ++m) {
                float s = 0.f;
#pragma unroll
                for (int bj = 0; bj < 2; ++bj)
#pragma unroll
                    for (int n = 0; n < 2; ++n) { const f32x4 x = v[ai][bj][m][n]; s += (x[0] + x[1]) + (x[2] + x[3]); }
                s += __shfl_xor(s, 16); s += __shfl_xor(s, 32);
                const float mw = s * (1.0f / 64.0f); float q = 0.f;
#pragma unroll
                for (int bj = 0; bj < 2; ++bj)
#pragma unroll
                    for (int n = 0; n < 2; ++n) { const f32x4 d = v[ai][bj][m][n] - mw; q += (d[0] * d[0] + d[1] * d[1]) + (d[2] * d[2] + d[3] * d[3]); }
                q += __shfl_xor(q, 16); q += __shfl_xor(q, 32);
                if (fq == 0) P[(ai * HALF + wr * 64 + m * 16 + fr) * 4 + wc] = (f32x2v){mw, q};
            }
        asm volatile("s_waitcnt lgkmcnt(0)" ::: "memory"); __builtin_amdgcn_s_barrier(); asm volatile("" ::: "memory");
#if defined(BROKEN_EXCHANGE_NO_WAIT)
#warning BROKEN CONTROL BUILD: the row-statistics exchange does not wait; results are wrong by design
        if (blockIdx.x >= 64) { const long long t0_ = clock64(); while (clock64() - t0_ < 60000) __builtin_amdgcn_s_sleep(8); }
#endif
        const int row = wid * 32 + (lane & 31);
        if (lane < 32) {
            const f32x2v a = P[row * 4 + 0], b = P[row * 4 + 1], c = P[row * 4 + 2], d = P[row * 4 + 3];
            const float mt = (a.x + b.x + c.x + d.x) * 0.25f;
            const float da = a.x - mt, db = b.x - mt, dc = c.x - mt, dd = d.x - mt;
            const float m2 = (a.y + b.y) + (c.y + d.y) + 64.0f * ((da * da + db * db) + (dc * dc + dd * dd));
            unsigned long long* slot = (unsigned long long*)xbuf + ((size_t)(u.pm * BM + row) * 4 + u.pn);
            __hip_atomic_store(slot, ((unsigned long long)__float_as_uint(m2) << 32) | __float_as_uint(mt), __ATOMIC_RELAXED, __HIP_MEMORY_SCOPE_AGENT);
        }
        asm volatile("s_waitcnt vmcnt(0)" ::: "memory");
        if (lane == 0) __hip_atomic_fetch_add(cnt + 64 * u.pm, 1u, __ATOMIC_RELAXED, __HIP_MEMORY_SCOPE_AGENT);
        if (wid == 0) {
            bool dead = false; const unsigned long long t0 = __builtin_amdgcn_s_memrealtime(); const unsigned want = 8u * (unsigned)ntn;
            for (;;) {
#if defined(BROKEN_EXCHANGE_NO_WAIT)
                break;
#endif
                if ((unsigned)__builtin_amdgcn_readfirstlane(__hip_atomic_load(cnt + 64 * u.pm, __ATOMIC_RELAXED, __HIP_MEMORY_SCOPE_AGENT)) >= want) break;
                if (__builtin_amdgcn_s_memrealtime() - t0 > 2000000ull) {
                    if (lane == 0) { unsigned expect = 0u; __hip_atomic_compare_exchange_strong(tmo + 1, &expect, code | (unsigned)(u.pm & 0xff), __ATOMIC_RELAXED, __ATOMIC_RELAXED, __HIP_MEMORY_SCOPE_AGENT);
                                     __hip_atomic_store(tmo, 1u, __ATOMIC_RELAXED, __HIP_MEMORY_SCOPE_AGENT); }
                    dead = true; break; }
                __builtin_amdgcn_s_sleep(2);
            }
            __builtin_amdgcn_fence(__ATOMIC_ACQUIRE, "agent");
            if (lane == 0) flag[0] = dead ? 1u : 0u;
        }
        asm volatile("s_waitcnt vmcnt(0) lgkmcnt(0)" ::: "memory"); __builtin_amdgcn_s_barrier(); asm volatile("" ::: "memory");
        const bool bad = flag[0] != 0u;
        if (lane < 32) {
            const unsigned long long* slot = (const unsigned long long*)xbuf + (size_t)(u.pm * BM + row) * 4; float mt[4], m2[4]; float ms = 0.f;
#pragma unroll
            for (int t = 0; t < 4; ++t) { if (t < ntn) { const unsigned long long w = __hip_atomic_load(slot + t, __ATOMIC_RELAXED, __HIP_MEMORY_SCOPE_AGENT); mt[t] = __uint_as_float((unsigned)w); m2[t] = __uint_as_float((unsigned)(w >> 32)); } else { mt[t] = 0.f; m2[t] = 0.f; } ms += mt[t]; }
            const float mean = ms / (float)ntn; float q = 0.f;
#pragma unroll
            for (int t = 0; t < 4; ++t) if (t < ntn) { const float dm = mt[t] - mean; q += m2[t] + 256.0f * dm * dm; }
            S[row] = (f32x2v){mean, 1.0f / sqrtf(q / (256.0f * (float)ntn) + eps)};
        }
        asm volatile("s_waitcnt lgkmcnt(0)" ::: "memory"); __builtin_amdgcn_s_barrier(); asm volatile("" ::: "memory");
        return bad;
    }
};
struct EpiLnRes {
    static constexpr bool PERM = false, AFTER_DRAIN = true;
    const float* base; float* out; int ldc; const float* bias; PanelStats st; unsigned poison;
    __device__ __forceinline__ void fused(f32x4 (&acc)[2][2][4][2], const Unit& u, int wr, int wc, int fr, int fq, PG8_LAS unsigned char* lds, int wid, int lane) const {
        typedef float f32x2v __attribute__((ext_vector_type(2)));
        const PG8_LAS f32x2v* S = (const PG8_LAS f32x2v*)(lds + 8192);
        const int col0 = u.pn * BM + wc * 32 + 4 * fq;
#pragma unroll
        for (int bj = 0; bj < 2; ++bj)
#pragma unroll
            for (int n = 0; n < 2; ++n) { const f32x4 bv = bias ? *(const f32x4*)(bias + col0 + bj * HALF + n * 16) : (f32x4){0.f, 0.f, 0.f, 0.f};
#pragma unroll
                for (int ai = 0; ai < 2; ++ai)
#pragma unroll
                    for (int m = 0; m < 4; ++m) acc[ai][bj][m][n] += bv; }
        f32x4 pre[4][2][2];
#pragma unroll
        for (int m = 0; m < 4; ++m) { const size_t off = (size_t)(u.pm * BM + wr * 64 + m * 16 + fr) * ldc + col0;
#pragma unroll
            for (int bj = 0; bj < 2; ++bj)
#pragma unroll
                for (int n = 0; n < 2; ++n) pre[m][bj][n] = *(const f32x4*)(base + off + bj * HALF + n * 16); }
        const bool bad = st.run(acc, u, wr, wc, fr, fq, lds, wid, lane) || poison != 0u;
        const float qnan = __builtin_nanf("");
#pragma unroll
        for (int ai = 0; ai < 2; ++ai)
#pragma unroll
            for (int m = 0; m < 4; ++m) { const int r = ai * HALF + wr * 64 + m * 16 + fr; const f32x2v sr = S[r]; const size_t off = (size_t)(u.pm * BM + r) * ldc + col0;
#pragma unroll
                for (int bj = 0; bj < 2; ++bj)
#pragma unroll
                    for (int n = 0; n < 2; ++n) { const f32x4 bs = ai == 0 ? pre[m][bj][n] : *(const f32x4*)(base + off + bj * HALF + n * 16); f32x4 o = bs + (acc[ai][bj][m][n] - sr.x) * sr.y;
                        if (bad) o = (f32x4){qnan, qnan, qnan, qnan}; *(f32x4*)(out + off + bj * HALF + n * 16) = o; }
                if (m & 1) asm volatile("" ::: "memory"); }
    }
};
struct EpiLnResLn {
    static constexpr bool PERM = false, AFTER_DRAIN = true;
    const float* base; float* out; bf16_t* xn; int ldc; const float* bias; PanelStats st1, st2; unsigned poison;
    __device__ __forceinline__ void fused(f32x4 (&acc)[2][2][4][2], const Unit& u, int wr, int wc, int fr, int fq, PG8_LAS unsigned char* lds, int wid, int lane) const {
        typedef float f32x2v __attribute__((ext_vector_type(2))); typedef unsigned u32x2v __attribute__((ext_vector_type(2)));
        const PG8_LAS f32x2v* S = (const PG8_LAS f32x2v*)(lds + 8192);
        const int col0 = u.pn * BM + wc * 32 + 4 * fq;
#pragma unroll
        for (int bj = 0; bj < 2; ++bj)
#pragma unroll
            for (int n = 0; n < 2; ++n) { const f32x4 bv = bias ? *(const f32x4*)(bias + col0 + bj * HALF + n * 16) : (f32x4){0.f, 0.f, 0.f, 0.f};
#pragma unroll
                for (int ai = 0; ai < 2; ++ai)
#pragma unroll
                    for (int m = 0; m < 4; ++m) acc[ai][bj][m][n] += bv; }
        bool bad = st1.run(acc, u, wr, wc, fr, fq, lds, wid, lane) || poison != 0u;
        const float qnan = __builtin_nanf("");
#pragma unroll
        for (int ai = 0; ai < 2; ++ai)
#pragma unroll
            for (int m = 0; m < 4; ++m) { const int r = ai * HALF + wr * 64 + m * 16 + fr; const f32x2v sr = S[r]; const size_t off = (size_t)(u.pm * BM + r) * ldc + col0;
#pragma unroll
                for (int bj = 0; bj < 2; ++bj)
#pragma unroll
                    for (int n = 0; n < 2; ++n) { const f32x4 bs = *(const f32x4*)(base + off + bj * HALF + n * 16); acc[ai][bj][m][n] = bs + (acc[ai][bj][m][n] - sr.x) * sr.y; }
                asm volatile("" : "+v"(acc[ai][0][m][0]), "+v"(acc[ai][0][m][1]), "+v"(acc[ai][1][m][0]), "+v"(acc[ai][1][m][1]));
                if (m & 1) asm volatile("" ::: "memory"); }
        const bool bad1 = bad;
        bad = st2.run(acc, u, wr, wc, fr, fq, lds, wid, lane) || bad;
#pragma unroll
        for (int ai = 0; ai < 2; ++ai)
#pragma unroll
            for (int m = 0; m < 4; ++m) { const int r = ai * HALF + wr * 64 + m * 16 + fr; const f32x2v sr = S[r]; const size_t off = (size_t)(u.pm * BM + r) * ldc + col0;
#pragma unroll
                for (int bj = 0; bj < 2; ++bj)
#pragma unroll
                    for (int n = 0; n < 2; ++n) { const f32x4 x1 = acc[ai][bj][m][n]; *(f32x4*)(out + off + bj * HALF + n * 16) = bad1 ? (f32x4){qnan, qnan, qnan, qnan} : x1;
                        const f32x4 o = (x1 - sr.x) * sr.y; u32x2v w; w.x = cvt_pk_bf16(o[0], o[1]); w.y = cvt_pk_bf16(o[2], o[3]);
                        if (bad) { w.x = 0x7fc07fc0u; w.y = 0x7fc07fc0u; } *(u32x2v*)(xn + off + bj * HALF + n * 16) = w; }
                asm volatile("" ::: "memory"); }
    }
};

typedef int i32x4_ __attribute__((ext_vector_type(4)));
typedef int i32x8_ __attribute__((ext_vector_type(8)));
__device__ __forceinline__ i32x8_ cat8(bf16x8 lo, bf16x8 hi) { return __builtin_shufflevector(__builtin_bit_cast(i32x4_, lo), __builtin_bit_cast(i32x4_, hi), 0, 1, 2, 3, 4, 5, 6, 7); }
template <class Epi, class Sched, bool ALIGN_EPI = false, bool SP2 = false, bool F8 = false>
__device__ __forceinline__ void gemm_phase(PG8_LAS unsigned char* lds, const Gemm g, const Sched& S, const Epi& E) {
    int tid_ = threadIdx.x; asm volatile("" : "+v"(tid_));
    const int tid = tid_, wid = __builtin_amdgcn_readfirstlane(tid >> 6), lane = tid & 63, wr = wid >> 2, wc = wid & 3, fr = lane & 15, fq = lane >> 4;
    int K_ = g.K; asm volatile("" : "+s"(K_));
    int LD_ = g.ld ? g.ld : K_; asm volatile("" : "+s"(LD_));
    const int K = K_, nt = K / BK, LD = LD_;
    unsigned voffA[2], voffB[2];
#pragma unroll
    for (int i = 0; i < 2; ++i) { int R, C; stage_rc(tid * 16 + i * 8192, R, C); const int Rb = Epi::PERM ? ((R & ~31) + perm32(R & 31)) : R;
        voffA[i] = (unsigned)(R * LD + C) * 2u; voffB[i] = (unsigned)(Rb * LD + C) * 2u; }
    const size_t kstep = (size_t)(BK * 2);
    const size_t hstep = (size_t)HALF * LD * 2;
    const size_t tstep = 2 * hstep;
    const unsigned ldsw = (unsigned)wid * 1024u;
    const int aoff = lds_byte(wr * 64 + fr, fq * 8), boff = F8 ? aoff + __builtin_amdgcn_readfirstlane(wc * 4096 - wr * 8192) : lds_byte(wc * 32 + fr, fq * 8);
#define PG8_SA(b, h) (((b) * 2 + (h)) * HTB)
#define PG8_SB(b, h) ((4 + (b) * 2 + (h)) * HTB)
#define PG8_STAGE(bufoff, gbase, voff) do { _Pragma("unroll") for (int _i = 0; _i < 2; ++_i) { \
        if constexpr (F8) { unsigned vo_ = (voff)[0]; asm volatile("" : "+v"(vo_));     \
            __builtin_amdgcn_global_load_lds((const unsigned*)((const char*)(gbase) + (size_t)_i * 128 * LD + vo_), (PG8_LAS unsigned*)(lds + (bufoff) + ldsw + _i * 8192), 16, 0, 0); } \
        else __builtin_amdgcn_global_load_lds((const unsigned*)((const char*)(gbase) + (voff)[_i]), (PG8_LAS unsigned*)(lds + (bufoff) + ldsw + _i * 8192), 16, 0, 0); } } while (0)
#define PG8_LDA(dst, b, h) do { _Pragma("unroll") for (int m = 0; m < 4; ++m) _Pragma("unroll") for (int k = 0; k < 2; ++k) dst[m][k] = *(const PG8_LAS bf16x8*)(lds + PG8_SA(b, h) + aoff + m * 2048 + k * 1024); } while (0)
#define PG8_LDB(dst, b, h) do { _Pragma("unroll") for (int n = 0; n < 2; ++n) _Pragma("unroll") for (int k = 0; k < 2; ++k) dst[n][k] = *(const PG8_LAS bf16x8*)(lds + PG8_SB(b, h) + boff + n * 2048 + k * 1024); } while (0)
#define PG8_MMA(ai, bj, At, Bt) do { __builtin_amdgcn_s_setprio(1); \
        if constexpr (F8) { _Pragma("unroll") for (int m = 0; m < 4; ++m) _Pragma("unroll") for (int n = 0; n < 2; ++n) \
            acc[ai][bj][m][n] = __builtin_amdgcn_mfma_scale_f32_16x16x128_f8f6f4(cat8(Bt[n][0], Bt[n][1]), cat8(At[m][0], At[m][1]), acc[ai][bj][m][n], 0, 0, 0, f8one, 0, f8one); } \
        else { _Pragma("unroll") for (int m = 0; m < 4; ++m) _Pragma("unroll") for (int n = 0; n < 2; ++n) _Pragma("unroll") for (int k = 0; k < 2; ++k) \
            acc[ai][bj][m][n] = __builtin_amdgcn_mfma_f32_16x16x32_bf16(Bt[n][k], At[m][k], acc[ai][bj][m][n], 0, 0, 0); } \
        __builtin_amdgcn_s_setprio(0); } while (0)
#define PG8_WAIT_V(n) asm volatile("s_waitcnt vmcnt(" #n ")" ::: "memory")
#define PG8_WAIT_L(n) asm volatile("s_waitcnt lgkmcnt(" #n ")" ::: "memory")
#define PG8_BAR __builtin_amdgcn_s_barrier()
#define PG8_SCHED __builtin_amdgcn_sched_barrier(0)
    int f8one = 0x7f7f7f7f; asm volatile("" : "+s"(f8one));
    Unit cur, nxt; int ui = 0;
    if (!S.next(0, cur)) return;
    f32x4 acc[2][2][4][2];
#pragma unroll
    for (int a = 0; a < 2; ++a)
#pragma unroll
        for (int b = 0; b < 2; ++b)
#pragma unroll
            for (int m = 0; m < 4; ++m)
#pragma unroll
                for (int n = 0; n < 2; ++n) acc[a][b][m][n] = (f32x4){0.f, 0.f, 0.f, 0.f};
    bf16x8 At[4][2], B0[2][2], B1[2][2];
    const char* cA = (const char*)g.A + S.a_base_off(cur) + (size_t)cur.pm * tstep; const char* cB = (const char*)g.Bt + S.b_base_off(cur) + (size_t)cur.pn * tstep;
    S.a_ready(cur);
    if constexpr (SP2) {
        PG8_STAGE(PG8_SB(0, 0), cB, voffB); PG8_STAGE(PG8_SB(0, 1), cB + hstep, voffB); PG8_STAGE(PG8_SA(0, 0), cA, voffA); PG8_STAGE(PG8_SA(0, 1), cA + hstep, voffA);
        if (wr == 1) PG8_BAR;
        PG8_WAIT_V(2); PG8_BAR;
        PG8_STAGE(PG8_SB(1, 0), cB + kstep, voffB); PG8_STAGE(PG8_SA(1, 0), cA + kstep, voffA); PG8_STAGE(PG8_SB(1, 1), cB + hstep + kstep, voffB);
        PG8_WAIT_V(6); PG8_BAR;
    } else {
        PG8_STAGE(PG8_SB(0, 0), cB, voffB); PG8_STAGE(PG8_SA(0, 0), cA, voffA); PG8_STAGE(PG8_SB(0, 1), cB + hstep, voffB); PG8_STAGE(PG8_SA(0, 1), cA + hstep, voffA);
        if (wr == 1) PG8_BAR;
        PG8_WAIT_V(4); PG8_BAR;
        PG8_STAGE(PG8_SB(1, 0), cB + kstep, voffB); PG8_STAGE(PG8_SA(1, 0), cA + kstep, voffA); PG8_STAGE(PG8_SB(1, 1), cB + hstep + kstep, voffB);
        PG8_WAIT_V(6); PG8_BAR;
    }
    for (;;) {
        const bool has_next = S.next(ui + 1, nxt);
        const char* nA = has_next ? (const char*)g.A + S.a_base_off(nxt) + (size_t)nxt.pm * tstep : cA; const char* nB = has_next ? (const char*)g.Bt + S.b_base_off(nxt) + (size_t)nxt.pn * tstep : cB;
        for (int t = 0; t < nt; t += 2) {
            const bool last = (t == nt - 2);
            const char* a1 = cA + (size_t)(t + 1) * kstep;
            const char* a2 = last ? nA : cA + (size_t)(t + 2) * kstep; const char* b2 = last ? nB : cB + (size_t)(t + 2) * kstep;
            const char* a3 = a2 + kstep; const char* b3 = b2 + kstep;
            if (last && has_next) S.a_ready(nxt);
            if constexpr (SP2) {
            PG8_LDB(B0, 0, 0); PG8_LDB(B1, 0, 1); PG8_SCHED; PG8_LDA(At, 0, 0); PG8_STAGE(PG8_SA(1, 1), a1 + hstep, voffA);
            PG8_WAIT_V(8); PG8_WAIT_L(0); PG8_BAR; PG8_MMA(0, 0, At, B0); PG8_MMA(0, 1, At, B1); PG8_BAR; PG8_SCHED;
            PG8_LDA(At, 0, 1); PG8_STAGE(PG8_SB(0, 0), b2, voffB); PG8_STAGE(PG8_SB(0, 1), b2 + hstep, voffB); PG8_STAGE(PG8_SA(0, 0), a2, voffA);
            PG8_WAIT_V(8); PG8_WAIT_L(0); PG8_BAR; PG8_MMA(1, 0, At, B0); PG8_MMA(1, 1, At, B1); PG8_BAR; PG8_SCHED;
            PG8_LDB(B0, 1, 0); PG8_LDB(B1, 1, 1); PG8_SCHED; PG8_LDA(At, 1, 0); PG8_STAGE(PG8_SA(0, 1), a2 + hstep, voffA);
            PG8_WAIT_V(8); PG8_WAIT_L(0); PG8_BAR; PG8_MMA(0, 0, At, B0); PG8_MMA(0, 1, At, B1); PG8_BAR; PG8_SCHED;
            PG8_LDA(At, 1, 1); PG8_STAGE(PG8_SB(1, 0), b3, voffB); PG8_STAGE(PG8_SB(1, 1), b3 + hstep, voffB); PG8_STAGE(PG8_SA(1, 0), a3, voffA);
            PG8_WAIT_V(8); PG8_WAIT_L(0); PG8_BAR; PG8_MMA(1, 0, At, B0); PG8_MMA(1, 1, At, B1); PG8_BAR; PG8_SCHED;
            } else {
            PG8_LDB(B0, 0, 0); PG8_SCHED; PG8_LDA(At, 0, 0); PG8_STAGE(PG8_SA(1, 1), a1 + hstep, voffA);
            PG8_WAIT_L(8); PG8_BAR; PG8_WAIT_L(0); PG8_MMA(0, 0, At, B0); PG8_BAR; PG8_SCHED;
            PG8_LDB(B1, 0, 1); PG8_STAGE(PG8_SB(0, 0), b2, voffB);
            PG8_BAR; PG8_WAIT_L(0); PG8_MMA(0, 1, At, B1); PG8_BAR;
            PG8_LDA(At, 0, 1); PG8_STAGE(PG8_SA(0, 0), a2, voffA);
            PG8_BAR; PG8_WAIT_L(0); PG8_MMA(1, 0, At, B0); PG8_BAR; PG8_SCHED;
            PG8_STAGE(PG8_SB(0, 1), b2 + hstep, voffB);
            PG8_WAIT_V(6); PG8_BAR; PG8_MMA(1, 1, At, B1); PG8_BAR;
            PG8_LDB(B0, 1, 0); PG8_SCHED; PG8_LDA(At, 1, 0); PG8_STAGE(PG8_SA(0, 1), a2 + hstep, voffA);
            PG8_WAIT_L(8); PG8_BAR; PG8_WAIT_L(0); PG8_MMA(0, 0, At, B0); PG8_BAR; PG8_SCHED;
            PG8_LDB(B1, 1, 1); PG8_STAGE(PG8_SB(1, 0), b3, voffB);
            PG8_BAR; PG8_WAIT_L(0); PG8_MMA(0, 1, At, B1); PG8_BAR;
            PG8_LDA(At, 1, 1); PG8_STAGE(PG8_SA(1, 0), a3, voffA);
            PG8_BAR; PG8_WAIT_L(0); PG8_MMA(1, 0, At, B0); PG8_BAR; PG8_SCHED;
            PG8_STAGE(PG8_SB(1, 1), b3 + hstep, voffB);
            PG8_WAIT_V(6); PG8_BAR; PG8_MMA(1, 1, At, B1); PG8_BAR;
            }
        }
        if constexpr (ALIGN_EPI) { if (wr == 0) PG8_BAR; }
        int fr_e = fr, fq_e = fq; if constexpr (F8) { int t2_ = threadIdx.x; asm volatile("" : "+v"(t2_)); fr_e = t2_ & 15; fq_e = (t2_ & 63) >> 4; }
        if constexpr (!Epi::AFTER_DRAIN) { E(acc, cur, wr, wc, fr_e, fq_e); S.done(cur); }
        if (!has_next) break;
#pragma unroll
        for (int a = 0; a < 2; ++a)
#pragma unroll
            for (int b = 0; b < 2; ++b)
#pragma unroll
                for (int m = 0; m < 4; ++m)
#pragma unroll
                    for (int n = 0; n < 2; ++n) acc[a][b][m][n] = (f32x4){0.f, 0.f, 0.f, 0.f};
        cur = nxt; cA = nA; cB = nB; ++ui;
        if constexpr (ALIGN_EPI) { if (wr == 1) PG8_BAR; }
    }
    PG8_WAIT_V(0);
    if constexpr (!ALIGN_EPI) { if (wr == 0) PG8_BAR; }
    PG8_BAR;
    if constexpr (Epi::AFTER_DRAIN) { E.fused(acc, cur, wr, wc, fr, fq, lds, wid, lane); S.done(cur); }
#undef PG8_SA
#undef PG8_SB
#undef PG8_STAGE
#undef PG8_LDA
#undef PG8_LDB
#undef PG8_MMA
#undef PG8_WAIT_V
#undef PG8_WAIT_L
#undef PG8_BAR
#undef PG8_SCHED
}
}

namespace pg8 {
struct EpiF32 {
    static constexpr bool PERM = false, AFTER_DRAIN = false;
    float* O; int ldc;
    __device__ __forceinline__ void operator()(const f32x4 (&acc)[2][2][4][2], const Unit& u, int wr, int wc, int fr, int fq) const {
        const int row0 = u.pm * BM + wr * 64 + fr, col0 = u.pn * BM + wc * 32 + 4 * fq;
#pragma unroll
        for (int ai = 0; ai < 2; ++ai)
#pragma unroll
            for (int m = 0; m < 4; ++m) { float* rowp = O + (size_t)(row0 + ai * HALF + m * 16) * ldc + col0;
#pragma unroll
                for (int bj = 0; bj < 2; ++bj)
#pragma unroll
                    for (int n = 0; n < 2; ++n) *(f32x4*)(rowp + bj * HALF + n * 16) = acc[ai][bj][m][n]; }
    }
};
__device__ __forceinline__ float silu_mul(float g, float u) { return g * __builtin_amdgcn_rcpf(1.0f + __expf(-g)) * u; }
template <bool O8> struct EpiSwigluT {
    static constexpr bool PERM = true, AFTER_DRAIN = false;
    bf16_t* O; int ldc; float sc; float osc = 1.f;
    __device__ __forceinline__ void operator()(const f32x4 (&acc)[2][2][4][2], const Unit& u, int wr, int wc, int fr, int fq) const {
        const int row0 = u.pm * BM + wr * 64 + fr, col0 = u.pn * HALF + wc * 32 + 8 * fq;
#pragma unroll
        for (int ai = 0; ai < 2; ++ai)
#pragma unroll
            for (int m = 0; m < 4; ++m) { bf16_t* rowp = O + (size_t)(row0 + ai * HALF + m * 16) * ldc + col0;
                const float c1 = -1.4426950408889634f * sc, kk = sc * sc * (O8 ? osc : 1.f);
                f32x2 r[4];
#pragma unroll
                for (int hf = 0; hf < 4; ++hf) { const f32x4 gq = acc[ai][0][m][hf >> 1], uq = acc[ai][1][m][hf >> 1];
                    const f32x2 ga = (hf & 1) ? (f32x2){gq[2], gq[3]} : (f32x2){gq[0], gq[1]}, ua = (hf & 1) ? (f32x2){uq[2], uq[3]} : (f32x2){uq[0], uq[1]};
                    const f32x2 t = ga * c1; f32x2 e; e.x = __builtin_amdgcn_exp2f(t.x); e.y = __builtin_amdgcn_exp2f(t.y);
                    const f32x2 d = e + 1.0f; f32x2 q; q.x = __builtin_amdgcn_rcpf(d.x); q.y = __builtin_amdgcn_rcpf(d.y);
                    r[hf] = ((ga * kk) * ua) * q; }
                if constexpr (O8) { unsigned char* rp8 = (unsigned char*)O + (size_t)(row0 + ai * HALF + m * 16) * ldc + col0; int w0 = 0, w1 = 0;
                    w0 = __builtin_amdgcn_cvt_pk_fp8_f32(r[0].x, r[0].y, w0, false); w0 = __builtin_amdgcn_cvt_pk_fp8_f32(r[1].x, r[1].y, w0, true);
                    w1 = __builtin_amdgcn_cvt_pk_fp8_f32(r[2].x, r[2].y, w1, false); w1 = __builtin_amdgcn_cvt_pk_fp8_f32(r[3].x, r[3].y, w1, true);
                    typedef unsigned u32x2_ __attribute__((ext_vector_type(2))); *(u32x2_*)rp8 = (u32x2_){(unsigned)w0, (unsigned)w1}; continue; }
                u32x4 w;
                w.x = cvt_pk_bf16(r[0].x, r[0].y); w.y = cvt_pk_bf16(r[1].x, r[1].y); w.z = cvt_pk_bf16(r[2].x, r[2].y); w.w = cvt_pk_bf16(r[3].x, r[3].y);
                *(u32x4*)rowp = w; }
    }
};
typedef EpiSwigluT<false> EpiSwiglu;
struct EpiPlane {
    static constexpr bool PERM = true, AFTER_DRAIN = false;
    bf16_t* O;
    __device__ __forceinline__ void operator()(const f32x4 (&acc)[2][2][4][2], const Unit& u, int wr, int wc, int fr, int fq) const {
        const int row0 = u.pm * BM + wr * 64 + fr, col0 = u.pn * BM + wc * 32 + 8 * fq;
#pragma unroll
        for (int ai = 0; ai < 2; ++ai)
#pragma unroll
            for (int m = 0; m < 4; ++m) { const int row = row0 + ai * HALF + m * 16;
#pragma unroll
                for (int bj = 0; bj < 2; ++bj) { const int col = col0 + bj * HALF;
                    bf16_t* dst = O + ((((size_t)(row >> 12) * 56 + (col >> 6)) * 4096 + (row & 4095)) * 64 + (col & 63));
                    const f32x4 v0 = acc[ai][bj][m][0], v1 = acc[ai][bj][m][1]; u32x4 w; w.x = cvt_pk_bf16(v0[0], v0[1]); w.y = cvt_pk_bf16(v0[2], v0[3]); w.z = cvt_pk_bf16(v1[0], v1[1]); w.w = cvt_pk_bf16(v1[2], v1[3]);
                    *(u32x4*)dst = w; } }
    }
};
struct MoeOrder : StaticOrder {
    int pm_off; int pend[8]; size_t estride;
    __device__ __forceinline__ size_t b_base_off(const Unit& u) const {
        const int rb = (u.pm + pm_off) * BM; int e = 0;
#pragma unroll
        for (int k = 0; k < 7; ++k) e += (rb >= pend[k]) ? 1 : 0;
        return (size_t)__builtin_amdgcn_readfirstlane(e) * estride;
    }
};
struct MoeSubOrder {
    int nsub, G, c, pm_lo; int pend[8]; size_t estride;
    __device__ __forceinline__ bool next(int i, Unit& u) const { const long s = (long)i * G + c; if (s >= nsub) return false; const int tile = (int)s / 7; u.kp = (int)s % 7; u.pm = pm_lo + (tile >> 2); u.pn = tile & 3; return true; }
    __device__ __forceinline__ void a_ready(const Unit&) const {}
    __device__ __forceinline__ void done(const Unit&) const {}
    int kbytes = 1024;
    __device__ __forceinline__ size_t a_base_off(const Unit& u) const { return (size_t)u.kp * kbytes; }
    __device__ __forceinline__ size_t b_base_off(const Unit& u) const {
        const int rb = u.pm * BM; int e = 0;
#pragma unroll
        for (int k = 0; k < 7; ++k) e += (rb >= pend[k]) ? 1 : 0;
        return (size_t)__builtin_amdgcn_readfirstlane(e) * estride + (size_t)u.kp * kbytes;
    }
};
struct EpiSlab {
    static constexpr bool PERM = true, AFTER_DRAIN = false;
    bf16_t* O; int pm_lo; size_t slab_stride; float sc = 1.f;
    __device__ __forceinline__ void operator()(const f32x4 (&acc)[2][2][4][2], const Unit& u, int wr, int wc, int fr, int fq) const {
        const int row0 = (u.pm - pm_lo) * BM + wr * 64 + fr, col0 = u.pn * BM + wc * 32 + 8 * fq; bf16_t* base = O + (size_t)u.kp * slab_stride;
#pragma unroll
        for (int ai = 0; ai < 2; ++ai)
#pragma unroll
            for (int m = 0; m < 4; ++m) { bf16_t* rowp = base + (size_t)(row0 + ai * HALF + m * 16) * 1024 + col0;
#pragma unroll
                for (int bj = 0; bj < 2; ++bj) { const f32x4 v0 = acc[ai][bj][m][0] * sc, v1 = acc[ai][bj][m][1] * sc; u32x4 w; w.x = cvt_pk_bf16(v0[0], v0[1]); w.y = cvt_pk_bf16(v0[2], v0[3]); w.z = cvt_pk_bf16(v1[0], v1[1]); w.w = cvt_pk_bf16(v1[2], v1[3]);
                    *(u32x4*)(rowp + bj * HALF) = w; } }
    }
};
}

#ifndef DENSE_F8
#define DENSE_F8 0
#endif
#ifndef DENSE_DN_F8
#define DENSE_DN_F8 1
#endif
#ifndef MOE_DN_F8
#define MOE_DN_F8 1
#endif
#ifndef MOE_GU_F8
#define MOE_GU_F8 1
#endif
constexpr int NWAVES = 8, NTHR = 512;
constexpr int NB = 8, SEQ = 4096, D = 1024, T = NB * SEQ, DEPTH = 4;
constexpr int NIN = 3584;
constexpr int C_AQ = 1024, C_AK = 1536, C_AV = 2048, C_RQ = 2560, C_RK = 2816, C_RV = 3072, C_RG = 3328;
constexpr int FFD = 2816, FFE = 3584, NE = 8;
constexpr int MOE_ROWS = 2 * T + NE * 256;
constexpr int HID_HALF_BLKS = 132;
constexpr float LN_EPS = 1e-5f, ALPHA = 1.681792830507429f;

constexpr size_t MiB = 1u << 20;
constexpr size_t WS_CTL = 0, CTL_ZERO_BYTES = 1 * MiB;
constexpr size_t WS_TAB = 1 * MiB;
constexpr size_t WS_WIN = 4 * MiB, WS_WOUT = 32 * MiB, WS_WGU = 40 * MiB, WS_WD = 62 * MiB, WS_WGUE = 73 * MiB, WS_WDE = 185 * MiB;
constexpr size_t WS_XB = 241 * MiB, WS_SH = 305 * MiB, WS_END = (305 + 627) * MiB;
constexpr size_t SH_P = 0, SH_Y = 224 * MiB, SH_OP = 288 * MiB, SH_LSE = 384 * MiB, SH_RWS = 387 * MiB, SH_RTS = 531 * MiB;
constexpr size_t SH_H = 0, SH_HID = 64 * MiB, SH_HIDM = 0, SH_XG = 462 * MiB, SH_TOK = 594 * MiB, SH_SLAB = 596 * MiB;
static_assert((size_t)MOE_ROWS * FFE * 2 <= 462 * MiB && (size_t)T * FFD * 2 <= 462 * MiB && (size_t)MOE_ROWS * D * 2 <= 132 * MiB, "ffn buffers");
constexpr int CW_BAR = 4096;
constexpr size_t TABB_WUPT = 1310720, TABB_AUPT = TABB_WUPT + 131072, TABB_GUPT = TABB_AUPT + 131072;
constexpr int TAB_BIAS = 0, TAB_COS = 4096, TAB_SIN = 4096 + 4096 * 32, TAB_META = 4096 + 2 * 4096 * 32;
constexpr size_t TOK_TI = 0, TOK_TG = (size_t)T * 16, TOK_TP = TOK_TG + (size_t)T * 8, TOK_CW = TOK_TP + (size_t)T * 8;

constexpr int RING_OFF = 0, RING_BYTES = 131072, LDSCTL_OFF = RING_BYTES, MISC_OFF = LDSCTL_OFF + 320, LDS_BYTES = 147456;

#define GAS __attribute__((address_space(1)))
#define LAS __attribute__((address_space(3)))
typedef unsigned short bf16;
typedef unsigned v4u __attribute__((ext_vector_type(4)));
typedef unsigned v2u __attribute__((ext_vector_type(2)));
typedef int v4i __attribute__((ext_vector_type(4)));
typedef int v2i __attribute__((ext_vector_type(2)));
typedef float f32x4 __attribute__((ext_vector_type(4)));
typedef float f32x2 __attribute__((ext_vector_type(2)));
typedef GAS unsigned gu32;
#define RLX_AGENT __ATOMIC_RELAXED, __HIP_MEMORY_SCOPE_AGENT
#define LDS_WAIT() asm volatile("s_waitcnt lgkmcnt(0)" ::: "memory")
#define VM_WAIT() asm volatile("s_waitcnt vmcnt(0)" ::: "memory")
typedef float f32x2_t_ __attribute__((ext_vector_type(2))); typedef __bf16 bf16x2_t_ __attribute__((ext_vector_type(2)));
__device__ __forceinline__ unsigned pk2(float lo, float hi) { const f32x2_t_ v = {lo, hi}; return __builtin_bit_cast(unsigned, __builtin_convertvector(v, bf16x2_t_)); }
__device__ __forceinline__ unsigned pk2h(float lo, float hi) { return pk2(lo, hi); }
__device__ __forceinline__ unsigned pk4f8(float a, float b, float c, float d, float s) { int w = 0; w = __builtin_amdgcn_cvt_pk_fp8_f32(a * s, b * s, w, false); w = __builtin_amdgcn_cvt_pk_fp8_f32(c * s, d * s, w, true); return (unsigned)w; }
__device__ __forceinline__ unsigned f2bf(float f) { return pk2(f, 0.f) & 0xffffu; }
__device__ __forceinline__ float bflo(unsigned u) { return __builtin_bit_cast(float, u << 16); }
__device__ __forceinline__ float bfhi(unsigned u) { return __builtin_bit_cast(float, u & 0xffff0000u); }
__device__ __forceinline__ float bf2f(bf16 v) { return __builtin_bit_cast(float, (unsigned)v << 16); }
__device__ __forceinline__ size_t pix(size_t tok, int col) { return (((tok >> 12) * 56 + (size_t)(col >> 6)) * 4096 + (tok & 4095)) * 64 + (size_t)(col & 63); }
constexpr size_t PLANE = 4096 * 64;
#define PIN(x) asm volatile("" : "+v"(x))
__device__ __forceinline__ f32x4 zero4() { int zi = 0; asm volatile("" : "+s"(zi)); const float z = __builtin_bit_cast(float, zi); return (f32x4){z, z, z, z}; }
__device__ __forceinline__ float sigm(float x) { return __builtin_amdgcn_rcpf(1.0f + __expf(-x)); }
__device__ __forceinline__ float rdl(float v, int l) { return __builtin_bit_cast(float, __builtin_amdgcn_readlane(__builtin_bit_cast(int, v), l)); }
template <int CTRL, int RM, int BM, bool BC> __device__ __forceinline__ float dpp_f(float old, float v) {
    return __builtin_bit_cast(float, __builtin_amdgcn_update_dpp(__builtin_bit_cast(int, old), __builtin_bit_cast(int, v), CTRL, RM, BM, BC)); }
__device__ __forceinline__ float wave_sum(float v) {
    v += dpp_f<0x111, 0xf, 0xf, true>(0.f, v); v += dpp_f<0x112, 0xf, 0xf, true>(0.f, v); v += dpp_f<0x114, 0xf, 0xf, true>(0.f, v); v += dpp_f<0x118, 0xf, 0xf, true>(0.f, v);
    v += dpp_f<0x142, 0xa, 0xf, false>(0.f, v); v += dpp_f<0x143, 0xc, 0xf, false>(0.f, v);
    return __builtin_bit_cast(float, __builtin_amdgcn_readlane(__builtin_bit_cast(int, v), 63)); }
__device__ __forceinline__ float sum16(float v) {
    v += dpp_f<0xB1, 0xf, 0xf, true>(0.f, v); v += dpp_f<0x4E, 0xf, 0xf, true>(0.f, v); v += dpp_f<0x141, 0xf, 0xf, true>(0.f, v); v += dpp_f<0x140, 0xf, 0xf, true>(0.f, v); return v; }
__device__ __forceinline__ void swap16(float& a, float& b) { asm volatile("s_nop 1\n\tv_permlane16_swap_b32 %0, %1\n\ts_nop 1" : "+v"(a), "+v"(b)); }
__device__ __forceinline__ void swap32(float& a, float& b) { asm volatile("s_nop 1\n\tv_permlane32_swap_b32 %0, %1\n\ts_nop 1" : "+v"(a), "+v"(b)); }
__device__ __forceinline__ float max_x4(float x) { float a = x, b = x; swap16(a, b); x = fmaxf(a, b); a = x; b = x; swap32(a, b); return fmaxf(a, b); }
__device__ __forceinline__ float sum_x4(float x) { float a = x, b = x; swap16(a, b); x = a + b; a = x; b = x; swap32(a, b); return a + b; }
__device__ __forceinline__ float xor32(float x, int lane) { float a = x, b = x; swap32(a, b); return lane < 32 ? b : a; }

#define XB_TMO      128
#define XB_XCNT(j)  (256  + 64 * (j))
#define XB_XSUB(j)  (1280 + 64 * (j))
#define XB_XGEN(j)  (2304 + 64 * (j))
#define XB_TOP      3328
#define XB_TOPGEN   3392
#define XCD_BAR_WORDS 3456
#define XB_SPIN_CAP (1u << 18)

__device__ __forceinline__ unsigned xb_ld(unsigned* p)              { return __hip_atomic_load(p, __ATOMIC_RELAXED, __HIP_MEMORY_SCOPE_AGENT); }
__device__ __forceinline__ unsigned xb_add(unsigned* p, unsigned v) { return __hip_atomic_fetch_add(p, v, __ATOMIC_RELAXED, __HIP_MEMORY_SCOPE_AGENT); }
__device__ __forceinline__ unsigned xb_xcc_id() { return (unsigned)__builtin_amdgcn_s_getreg((3 << 11) | 20) & 0xFu; }
#define XB_SPIN(cond, bar) do { unsigned _sp = 0; while (cond) { __builtin_amdgcn_s_sleep(1); \
    if ((++_sp & 255u) == 0u) { if (xb_ld(&(bar)[XB_TMO])) break; if (_sp > XB_SPIN_CAP) { atomicAdd(&(bar)[XB_TMO], 1u); break; } } } } while (0)

struct XcdBarrier {
    unsigned* bar; unsigned x;
    volatile LAS unsigned* st;
};

__device__ __forceinline__ XcdBarrier xcd_barrier_post(unsigned* bar, volatile LAS unsigned* st) {
    XcdBarrier b; b.bar = bar; b.x = xb_xcc_id(); b.st = st;
    if (threadIdx.x == 0) (void)xb_add(&bar[XB_XCNT(b.x)], 1u);
    return b;
}
__device__ __forceinline__ void xcd_barrier_complete(unsigned* bar, unsigned x, unsigned& nloc, unsigned& nx) {
    const unsigned G = gridDim.x * gridDim.y * gridDim.z;
    unsigned sum, cnt, mine, sp = 0u;
    for (;;) {
        sum = 0u; cnt = 0u; mine = 0u;
#pragma unroll
        for (unsigned j = 0; j < 16; ++j) { const unsigned c = xb_ld(&bar[XB_XCNT(j)]); sum += c; cnt += (c > 0u) ? 1u : 0u; mine = (j == x) ? c : mine; }
        if (sum == G) break;
        __builtin_amdgcn_s_sleep(1);
        if ((++sp & 255u) == 0u) { if (xb_ld(&bar[XB_TMO])) break; if (sp > XB_SPIN_CAP) { atomicAdd(&bar[XB_TMO], 1u); break; } }
    }
    nloc = mine > 0u ? mine : 1u; nx = cnt > 0u ? cnt : 1u;
}

__device__ __forceinline__ void xcd_barrier(const XcdBarrier& b) {
    asm volatile("s_waitcnt vmcnt(0)" ::: "memory");
    __syncthreads();
    if (threadIdx.x == 0) {
        unsigned* bar = b.bar;
        __builtin_amdgcn_s_waitcnt(0);
        unsigned nloc = b.st[0], nx = b.st[1];
        if (nloc == 0u) { xcd_barrier_complete(bar, b.x, nloc, nx); b.st[0] = nloc; b.st[1] = nx; }
        const unsigned old = xb_add(&bar[XB_XSUB(b.x)], 1u);
        const unsigned gen = old / nloc;
        if (old + 1u == (gen + 1u) * nloc) {
            __builtin_amdgcn_fence(__ATOMIC_RELEASE, "agent");
            asm volatile("s_waitcnt vmcnt(0)" ::: "memory");
            const unsigned og = xb_add(&bar[XB_TOP], 1u);
            const unsigned tg = og / nx;
            if (og + 1u == (tg + 1u) * nx) xb_add(&bar[XB_TOPGEN], 1u);
            else XB_SPIN(xb_ld(&bar[XB_TOPGEN]) == tg, bar);
            __builtin_amdgcn_fence(__ATOMIC_ACQUIRE, "agent");
            xb_add(&bar[XB_XGEN(b.x)], 1u);
            asm volatile("s_waitcnt vmcnt(0)" ::: "memory");
        } else {
            XB_SPIN(xb_ld(&bar[XB_XGEN(b.x)]) == gen, bar);
            __builtin_amdgcn_fence(__ATOMIC_ACQUIRE, "agent");
            asm volatile("s_waitcnt vmcnt(0)" ::: "memory");
        }
    }
    __syncthreads();
}


struct Frame {
    LAS unsigned char* lds;
    volatile LAS unsigned* MISC;
    gu32* ctl;
    int tid, lane, wave, G, bid, lo, hi;
    const float *x, *w_in, *w_out, *mu, *w0, *w_up, *a0, *a_up, *g_up, *k_k, *k_a, *r_k, *rln_g, *rln_b, *gn_g, *gn_b, *rel_bias, *ln_g, *ln_b;
    const float *ffn_g, *ffn_u, *ffn_d, *router, *moe_g, *moe_u, *moe_d;
    float* out;
    float* TAB;
    bf16 *WIN_T, *WOUT_T, *WGU_T, *WD_T, *WGUE, *WDE, *XB, *P, *Y, *HID, *HIDM, *XG;
    bf16 *HB;
    unsigned char* TOK; unsigned char* wsb;
};

constexpr float F8_WS = 256.f, F8_XS = 8.f, F8_HS = 8.f, F8_WDS = 1024.f;
__device__ __forceinline__ void transpose_item(const float* W, int K, int N, bf16* WT, LAS float* scr, int item, int lane, int mode, bool f8 = false, float f8s = F8_WS) {
    const int nblk = N / 32, kb = item / nblk, nb = item % nblk, k0 = 64 * kb, n0 = 32 * nb;
#pragma unroll 8
    for (int i = 0; i < 32; ++i) { const int kk = 2 * i + (lane >> 5); scr[kk * 33 + (lane & 31)] = W[(size_t)(k0 + kk) * N + n0 + (lane & 31)]; }
    LDS_WAIT(); asm volatile("" ::: "memory");
    const int drow0 = (mode == 0) ? n0 : ((n0 >> 7) * 256 + (n0 & 127) + (mode == 2 ? 128 : 0));
    const int c = lane & 7;
#pragma unroll
    for (int j = 0; j < 4; ++j) { const int n = (lane >> 3) + 8 * j; const LAS float* s = scr + (8 * c) * 33 + n;
        if (f8) { v2u o; o.x = pk4f8(s[0 * 33], s[1 * 33], s[2 * 33], s[3 * 33], f8s); o.y = pk4f8(s[4 * 33], s[5 * 33], s[6 * 33], s[7 * 33], f8s);
            *(GAS v2u*)((unsigned char*)WT + (size_t)(drow0 + n) * K + k0 + 8 * c) = o; }
        else { v4u o; o.x = pk2(s[0 * 33], s[1 * 33]); o.y = pk2(s[2 * 33], s[3 * 33]); o.z = pk2(s[4 * 33], s[5 * 33]); o.w = pk2(s[6 * 33], s[7 * 33]);
            *(GAS v4u*)(WT + (size_t)(drow0 + n) * K + k0 + 8 * c) = o; } }
    LDS_WAIT(); asm volatile("" ::: "memory");
}
__device__ __forceinline__ void convert_moe(Frame& F, int j) {
    LAS float* scr = (LAS float*)(F.lds + F.wave * 16384);
    const int gw = F.bid * NWAVES + F.wave, NGW = F.G * NWAVES;
    constexpr int I_E = 1792, PER_E = 3 * I_E, NIT = NE * PER_E;
    for (int it = gw; it < NIT; it += NGW) {
        const int e = it / PER_E; int r = it - e * PER_E;
        const size_t eo = (size_t)(j * NE + e) * D * FFE;
        if (r < I_E) transpose_item(F.moe_g + eo, D, FFE, MOE_GU_F8 ? (bf16*)((unsigned char*)F.WGUE + (size_t)e * 2 * FFE * D) : F.WGUE + (size_t)e * 2 * FFE * D, scr, r, F.lane, 1, MOE_GU_F8);
        else if (r < 2 * I_E) transpose_item(F.moe_u + eo, D, FFE, MOE_GU_F8 ? (bf16*)((unsigned char*)F.WGUE + (size_t)e * 2 * FFE * D) : F.WGUE + (size_t)e * 2 * FFE * D, scr, r - I_E, F.lane, 2, MOE_GU_F8);
        else transpose_item(F.moe_d + eo, FFE, D, MOE_DN_F8 ? (bf16*)((unsigned char*)F.WDE + (size_t)e * D * FFE) : F.WDE + (size_t)e * D * FFE, scr, r - 2 * I_E, F.lane, 0, MOE_DN_F8, F8_WDS);
    }
}
__device__ __forceinline__ void sincos_pos(double x, float& s, float& c) {
    const double kd = __builtin_rint(x * 0.63661977236758134308);
    const double r = (x - kd * 1.57079632679489655800e+00) - kd * 6.12323399573676603587e-17;
    const int k = (int)kd & 3; const double r2 = r * r;
    const double sp = r * (1.0 + r2 * (-1.0 / 6 + r2 * (1.0 / 120 + r2 * (-1.0 / 5040 + r2 * (1.0 / 362880 + r2 * (-1.0 / 39916800 + r2 * (1.0 / 6227020800.0)))))));
    const double cp = 1.0 + r2 * (-0.5 + r2 * (1.0 / 24 + r2 * (-1.0 / 720 + r2 * (1.0 / 40320 + r2 * (-1.0 / 3628800 + r2 * (1.0 / 479001600 + r2 * (-1.0 / 87178291200.0)))))));
    const double ss = (k == 0) ? sp : (k == 1) ? cp : (k == 2) ? -sp : -cp;
    const double cc = (k == 0) ? cp : (k == 1) ? -sp : (k == 2) ? -cp : sp;
    s = (float)ss; c = (float)cc;
}
__device__ __forceinline__ void ph_prologue(Frame& F) {
    LAS float* scr = (LAS float*)(F.lds + F.wave * 16384);
    const int gw = F.bid * NWAVES + F.wave, NGW = F.G * NWAVES;
    constexpr int I_IN = 16 * 112, I_OUT = 16 * 32, I_GU = 16 * 88, I_DN = 44 * 32;
    constexpr int PER_L = I_IN + I_OUT, PER_J = 2 * I_GU + I_DN, N1 = 4 * PER_L + 2 * PER_J;
    for (int it = gw; it < N1; it += NGW) {
        int r = it;
        if (r < 4 * PER_L) { const int l = r / PER_L; r -= l * PER_L;
            if (r < I_IN) transpose_item(F.w_in + (size_t)l * D * NIN, D, NIN, F.WIN_T + (size_t)l * NIN * D, scr, r, F.lane, 0);
            else transpose_item(F.w_out + (size_t)l * D * D, D, D, F.WOUT_T + (size_t)l * D * D, scr, r - I_IN, F.lane, 0);
        } else { r -= 4 * PER_L; const int j = r / PER_J; r -= j * PER_J;
            if (r < I_GU) transpose_item(F.ffn_g + (size_t)j * D * FFD, D, FFD, DENSE_F8 ? (bf16*)((unsigned char*)F.WGU_T + (size_t)j * 2 * FFD * D) : F.WGU_T + (size_t)j * 2 * FFD * D, scr, r, F.lane, 1, DENSE_F8, F8_WS);
            else if (r < 2 * I_GU) transpose_item(F.ffn_u + (size_t)j * D * FFD, D, FFD, DENSE_F8 ? (bf16*)((unsigned char*)F.WGU_T + (size_t)j * 2 * FFD * D) : F.WGU_T + (size_t)j * 2 * FFD * D, scr, r - I_GU, F.lane, 2, DENSE_F8, F8_WS);
            else transpose_item(F.ffn_d + (size_t)j * FFD * D, FFD, D, DENSE_DN_F8 ? (bf16*)((unsigned char*)F.WD_T + (size_t)j * D * FFD) : F.WD_T + (size_t)j * D * FFD, scr, r - 2 * I_GU, F.lane, 0, DENSE_DN_F8, F8_WDS);
        }
    }
    convert_moe(F, 0);
    { const size_t n8 = (size_t)T * D / 8;
      for (size_t i = (size_t)F.bid * NTHR + F.tid; i < n8; i += (size_t)F.G * NTHR) {
          const f32x4 a = ((const GAS f32x4*)F.x)[2 * i], b = ((const GAS f32x4*)F.x)[2 * i + 1];
          v4u o; o.x = pk2(a.x, a.y); o.y = pk2(a.z, a.w); o.z = pk2(b.x, b.y); o.w = pk2(b.z, b.w);
          ((GAS v4u*)F.XB)[i] = o; } }
    const int gt = F.bid * NTHR + F.tid;
    { bf16* WUPT = (bf16*)(F.wsb + WS_TAB + TABB_WUPT); bf16* AUPT = (bf16*)(F.wsb + WS_TAB + TABB_AUPT); bf16* GUPT = (bf16*)(F.wsb + WS_TAB + TABB_GUPT);
      for (int i = gt; i < 4 * 4 * 64 * 64; i += F.G * NTHR) { const int k = i & 63, c = (i >> 6) & 63, h = (i >> 12) & 3, l = i >> 14;
          WUPT[i] = (bf16)f2bf(F.w_up[((size_t)l * 64 + k) * 256 + h * 64 + c]); AUPT[i] = (bf16)f2bf(F.a_up[((size_t)l * 64 + k) * 256 + h * 64 + c]); }
      for (int i = gt; i < 4 * 4 * 64 * 128; i += F.G * NTHR) { const int k = i & 127, c = (i >> 7) & 63, h = (i >> 13) & 3, l = i >> 15;
          GUPT[i] = (bf16)f2bf(F.g_up[((size_t)l * 128 + k) * 256 + h * 64 + c]); } }
    if (gt < 3 * 8 * 129) {
        const int p = gt / 1032, h = (gt / 129) % 8, rel = gt % 129, dist = rel * (p == 0 ? 1 : (p == 1 ? 4 : 16));
        int b = dist;
        if (dist >= 16) { b = 16; b += dist >= 22; b += dist >= 30; b += dist >= 40; b += dist >= 54; b += dist >= 73; b += dist >= 99; b += dist >= 134; b += dist >= 182;
            b += dist >= 246; b += dist >= 332; b += dist >= 450; b += dist >= 609; b += dist >= 825; b += dist >= 1117; b += dist >= 1513; }
        F.TAB[TAB_BIAS + gt] = F.rel_bias[b * 8 + h];
    }
    for (int i = gt; i < SEQ * 32; i += F.G * NTHR) {
        const int pos = i >> 5, k = i & 31; double invd = 1.0;
        for (int q = 0; q < k; ++q) invd *= 0.7498942093324559;
        const float inv = (float)invd, ang = (float)pos * inv; float s, c; sincos_pos((double)ang, s, c);
        F.TAB[TAB_COS + i] = c; F.TAB[TAB_SIN + i] = s;
    }
}

__device__ __forceinline__ void unpack8(const v4u& a, float (&o)[8]) { o[0] = bflo(a.x); o[1] = bfhi(a.x); o[2] = bflo(a.y); o[3] = bfhi(a.y); o[4] = bflo(a.z); o[5] = bfhi(a.z); o[6] = bflo(a.w); o[7] = bfhi(a.w); }
#define LN_LOAD_GAINS float gv[16], bv[16]; \
    _Pragma("unroll") for (int j = 0; j < 2; ++j) _Pragma("unroll") for (int hh = 0; hh < 2; ++hh) { const f32x4 a = ((const GAS f32x4*)lg)[128 * j + 2 * F.lane + hh], b = ((const GAS f32x4*)lb)[128 * j + 2 * F.lane + hh]; \
            gv[8 * j + 4 * hh] = a.x; gv[8 * j + 4 * hh + 1] = a.y; gv[8 * j + 4 * hh + 2] = a.z; gv[8 * j + 4 * hh + 3] = a.w; \
            bv[8 * j + 4 * hh] = b.x; bv[8 * j + 4 * hh + 1] = b.y; bv[8 * j + 4 * hh + 2] = b.z; bv[8 * j + 4 * hh + 3] = b.w; }
template <int MODE, bool X32>
__device__ __forceinline__ void ph_ln(Frame& F, const float* x32, float* out32, const float* lg, const float* lb, const float* router, bf16* xb_out, bool dry, int lo_row = 0x7fffffff, const bf16* slab = nullptr, size_t slab_stride = 0, unsigned char* x8_out = nullptr) {
    constexpr int RG = (MODE == 0 && !X32) ? 8 : 4;
    GAS v4i* TI = (GAS v4i*)(F.TOK + TOK_TI); GAS f32x2* TG = (GAS f32x2*)(F.TOK + TOK_TG); GAS v2i* TP = (GAS v2i*)(F.TOK + TOK_TP); GAS int* CW = (GAS int*)(F.TOK + TOK_CW);
    for (int c = F.bid; c < T / 128; c += F.G) {
        int cnt[8];
#pragma unroll
        for (int e = 0; e < 8; ++e) cnt[e] = 0;
        const int tw = c * 128 + F.wave * 16;
        for (int grp = 0; grp < 16 / RG; ++grp) {
            v4u xa[RG][2], fa[RG][2], fb[RG][2]; f32x4 xf[RG][4]; f32x2 tgs[RG]; v2i tps[RG];
            if (MODE == 2) {
#pragma unroll
                for (int rr = 0; rr < RG; ++rr) { tps[rr] = TP[tw + grp * RG + rr]; tgs[rr] = TG[tw + grp * RG + rr]; }
#pragma unroll
                for (int rr = 0; rr < RG; ++rr) { const GAS v4u* y0 = (const GAS v4u*)(F.XG + (size_t)tps[rr].x * D) + F.lane; const GAS v4u* y1 = (const GAS v4u*)(F.XG + (size_t)tps[rr].y * D) + F.lane;
#pragma unroll
                    for (int j = 0; j < 2; ++j) { fa[rr][j] = y0[64 * j]; fb[rr][j] = y1[64 * j]; } } }
#pragma unroll
            for (int rr = 0; rr < RG; ++rr) { const int t = tw + grp * RG + rr;
                if (X32) { const GAS f32x4* xr = (const GAS f32x4*)(x32 + (size_t)t * D) + 2 * F.lane;
#pragma unroll
                    for (int j = 0; j < 2; ++j) { xf[rr][2 * j] = xr[128 * j]; xf[rr][2 * j + 1] = xr[128 * j + 1]; } }
                else { const GAS v4u* br = (const GAS v4u*)(F.XB + (size_t)t * D) + F.lane;
#pragma unroll
                    for (int j = 0; j < 2; ++j) xa[rr][j] = br[64 * j]; }
                if (MODE != 2) { const GAS v4u* hr = (const GAS v4u*)(F.HB + (size_t)t * D) + F.lane;
#pragma unroll
                    for (int j = 0; j < 2; ++j) fa[rr][j] = hr[64 * j]; } }
#pragma unroll
            for (int rr = 0; rr < RG; ++rr)
#pragma unroll
                for (int j = 0; j < 2; ++j) { if (X32) { PIN(xf[rr][2 * j]); PIN(xf[rr][2 * j + 1]); } else PIN(xa[rr][j]); PIN(fa[rr][j]); if (MODE == 2) PIN(fb[rr][j]); }
            float vn[MODE == 1 ? 4 : 1][16];
            { LN_LOAD_GAINS
#pragma unroll
            for (int rr = 0; rr < RG; ++rr) {
                const int t = tw + grp * RG + rr;
                float v[16];
#pragma unroll
                for (int j = 0; j < 2; ++j) {
                    float xx[8], ff[8];
                    if (X32) { xx[0] = xf[rr][2 * j].x; xx[1] = xf[rr][2 * j].y; xx[2] = xf[rr][2 * j].z; xx[3] = xf[rr][2 * j].w; xx[4] = xf[rr][2 * j + 1].x; xx[5] = xf[rr][2 * j + 1].y; xx[6] = xf[rr][2 * j + 1].z; xx[7] = xf[rr][2 * j + 1].w; }
                    else unpack8(xa[rr][j], xx);
                    unpack8(fa[rr][j], ff);
                    if (MODE == 2) { float f2[8]; unpack8(fb[rr][j], f2); const float g0 = tgs[rr].x, g1 = tgs[rr].y;
                        if (tps[rr].x >= lo_row) {
#pragma unroll
                            for (int k = 0; k < 8; ++k) ff[k] = 0.f;
                            for (int kp = 0; kp < 7; ++kp) { float t8[8]; const v4u sv = ((const GAS v4u*)(slab + (size_t)kp * slab_stride + (size_t)(tps[rr].x - lo_row) * D))[64 * j + F.lane]; unpack8(sv, t8);
#pragma unroll
                                for (int k = 0; k < 8; ++k) ff[k] += t8[k]; } }
                        if (tps[rr].y >= lo_row) {
#pragma unroll
                            for (int k = 0; k < 8; ++k) f2[k] = 0.f;
                            for (int kp = 0; kp < 7; ++kp) { float t8[8]; const v4u sv = ((const GAS v4u*)(slab + (size_t)kp * slab_stride + (size_t)(tps[rr].y - lo_row) * D))[64 * j + F.lane]; unpack8(sv, t8);
#pragma unroll
                                for (int k = 0; k < 8; ++k) f2[k] += t8[k]; } }
#pragma unroll
                        for (int k = 0; k < 8; ++k) v[8 * j + k] = ALPHA * xx[k] + g0 * ff[k] + g1 * f2[k]; }
                    else {
#pragma unroll
                        for (int k = 0; k < 8; ++k) v[8 * j + k] = ALPHA * xx[k] + ff[k]; } }
                float s = 0.f;
#pragma unroll
                for (int k = 0; k < 16; ++k) s += v[k];
                const float mean = wave_sum(s) * (1.f / D); float s2 = 0.f;
#pragma unroll
                for (int k = 0; k < 16; ++k) { v[k] -= mean; s2 += v[k] * v[k]; }
                const float rstd = __builtin_amdgcn_rsqf(wave_sum(s2) * (1.f / D) + LN_EPS);
#pragma unroll
                for (int k = 0; k < 16; ++k) v[k] = v[k] * rstd * gv[k] + bv[k];
                GAS v4u* brow = (GAS v4u*)(xb_out + (size_t)t * D) + F.lane;
#pragma unroll
                for (int j = 0; j < 2; ++j) { v4u o; o.x = pk2h(v[8 * j], v[8 * j + 1]); o.y = pk2h(v[8 * j + 2], v[8 * j + 3]); o.z = pk2h(v[8 * j + 4], v[8 * j + 5]); o.w = pk2h(v[8 * j + 6], v[8 * j + 7]); brow[64 * j] = o; }
                if (x8_out && !dry) { GAS v2u* xrow = (GAS v2u*)(x8_out + (size_t)t * D) + F.lane;
#pragma unroll
                    for (int j = 0; j < 2; ++j) { v2u o8; o8.x = pk4f8(v[8 * j], v[8 * j + 1], v[8 * j + 2], v[8 * j + 3], F8_XS); o8.y = pk4f8(v[8 * j + 4], v[8 * j + 5], v[8 * j + 6], v[8 * j + 7], F8_XS); xrow[64 * j] = o8; } }
                if (out32 && !dry) { GAS f32x4* orow = (GAS f32x4*)(out32 + (size_t)t * D) + 2 * F.lane;
#pragma unroll
                    for (int j = 0; j < 2; ++j) { orow[128 * j] = (f32x4){v[8 * j], v[8 * j + 1], v[8 * j + 2], v[8 * j + 3]}; orow[128 * j + 1] = (f32x4){v[8 * j + 4], v[8 * j + 5], v[8 * j + 6], v[8 * j + 7]}; } }
                if (MODE == 1) {
#pragma unroll
                    for (int k = 0; k < 16; ++k) vn[rr][k] = v[k]; }
            } }
            if (MODE == 1) {
                float lg[RG][8];
#pragma unroll
                for (int rr = 0; rr < RG; ++rr)
#pragma unroll
                    for (int e = 0; e < 8; ++e) lg[rr][e] = 0.f;
#pragma unroll
                for (int j = 0; j < 2; ++j) { const GAS f32x4* rp = (const GAS f32x4*)(router + (size_t)(512 * j + 8 * F.lane) * 8);
#pragma unroll
                    for (int k = 0; k < 8; ++k) { const f32x4 r0 = rp[2 * k], r1 = rp[2 * k + 1];
#pragma unroll
                        for (int rr = 0; rr < RG; ++rr) { const float xv = vn[rr][8 * j + k];
                            lg[rr][0] += xv * r0.x; lg[rr][1] += xv * r0.y; lg[rr][2] += xv * r0.z; lg[rr][3] += xv * r0.w; lg[rr][4] += xv * r1.x; lg[rr][5] += xv * r1.y; lg[rr][6] += xv * r1.z; lg[rr][7] += xv * r1.w; } } }
#pragma unroll
                for (int rr = 0; rr < RG; ++rr) { const int t = tw + grp * RG + rr;
                    float lg8[8];
#pragma unroll
                    for (int e = 0; e < 8; ++e) lg8[e] = wave_sum(lg[rr][e]);
                    int e0 = 0; float l0 = lg8[0];
#pragma unroll
                    for (int e = 1; e < 8; ++e) if (lg8[e] > l0) { l0 = lg8[e]; e0 = e; }
                    int e1 = -1; float l1 = -3.0e38f;
#pragma unroll
                    for (int e = 0; e < 8; ++e) if (e != e0 && lg8[e] > l1) { l1 = lg8[e]; e1 = e; }
                    const float g0 = 1.0f / (1.0f + __expf(l1 - l0)), g1 = 1.0f - g0;
                    int p0 = 0, p1 = 0;
#pragma unroll
                    for (int e = 0; e < 8; ++e) { if (e == e0) { p0 = cnt[e]; cnt[e] += 1; } if (e == e1) { p1 = cnt[e]; cnt[e] += 1; } }
                    if (F.lane == 0 && !dry) { TI[t] = (v4i){e0, e1, p0, p1}; TG[t] = (f32x2){g0, g1}; }
                }
            }
        }
        if (MODE == 1 && F.lane == 0 && !dry) {
#pragma unroll
            for (int e = 0; e < 8; ++e) CW[(c * 8 + F.wave) * 8 + e] = cnt[e];
        }
    }
}

__device__ __forceinline__ void ph_moe_gather(Frame& F) {
    LAS int* PS = (LAS int*)F.lds;
    LAS int* ST = PS + 512 * 8;
    LAS int* TOTL = ST + 64 * 8;
    GAS v4i* TI = (GAS v4i*)(F.TOK + TOK_TI); GAS v2i* TP = (GAS v2i*)(F.TOK + TOK_TP); GAS int* CW = (GAS int*)(F.TOK + TOK_CW);
    { int s[8];
#pragma unroll
      for (int e = 0; e < 8; ++e) s[e] = 0;
#pragma unroll
      for (int q = 0; q < 4; ++q) { const v4i a = *(const GAS v4i*)(CW + (F.tid * 4 + q) * 8), b = *(const GAS v4i*)(CW + (F.tid * 4 + q) * 8 + 4);
          s[0] += a.x; s[1] += a.y; s[2] += a.z; s[3] += a.w; s[4] += b.x; s[5] += b.y; s[6] += b.z; s[7] += b.w; }
#pragma unroll
      for (int e = 0; e < 8; ++e) PS[F.tid * 8 + e] = s[e]; }
    __syncthreads();
    { const int e = F.tid & 7, seg = F.tid >> 3; int run = 0;
#pragma unroll
      for (int i = 0; i < 8; ++i) { const int v = PS[(seg * 8 + i) * 8 + e]; PS[(seg * 8 + i) * 8 + e] = run; run += v; }
      ST[seg * 8 + e] = run; }
    __syncthreads();
    if (F.tid < 8) { int run = 0; for (int i = 0; i < 64; ++i) { const int v = ST[i * 8 + F.tid]; ST[i * 8 + F.tid] = run; run += v; } TOTL[F.tid] = run; }
    __syncthreads();
    if (F.tid == 0) { int ps = 0; for (int e = 0; e < 8; ++e) { const int pad = (TOTL[e] + 255) / 256 * 256; TOTL[8 + e] = ps; ps += pad; TOTL[16 + e] = ps; } }
    __syncthreads();
    if (F.bid == 0 && F.tid < 8) ((GAS int*)(F.TAB + TAB_META))[F.tid] = TOTL[16 + F.tid];
    for (int c = F.bid; c < T / 128; c += F.G) {
        int base[8];
#pragma unroll
        for (int e = 0; e < 8; ++e) { int b = TOTL[8 + e] + PS[(2 * c) * 8 + e] + ST[((2 * c) >> 3) * 8 + e];
            for (int w = 0; w < F.wave; ++w) b += CW[(c * 8 + w) * 8 + e];
            base[e] = b; }
        for (int grp = 0; grp < 4; ++grp) {
            v4i ti[4]; v4u ra[4], rb[4];
#pragma unroll
            for (int rr = 0; rr < 4; ++rr) { const int t = c * 128 + F.wave * 16 + grp * 4 + rr; ti[rr] = TI[t];
                const GAS v4u* src = (const GAS v4u*)(F.XB + (size_t)t * D) + F.lane; ra[rr] = src[0]; rb[rr] = src[64]; }
#pragma unroll
            for (int rr = 0; rr < 4; ++rr) { PIN(ra[rr]); PIN(rb[rr]); }
#pragma unroll
            for (int rr = 0; rr < 4; ++rr) { const int t = c * 128 + F.wave * 16 + grp * 4 + rr;
                int pos0 = ti[rr].z, pos1 = ti[rr].w;
#pragma unroll
                for (int e = 0; e < 8; ++e) { if (e == ti[rr].x) pos0 += base[e]; if (e == ti[rr].y) pos1 += base[e]; }
                if (MOE_GU_F8) {
                    v2u fa, fb; fa.x = pk4f8(bflo(ra[rr].x), bfhi(ra[rr].x), bflo(ra[rr].y), bfhi(ra[rr].y), F8_XS); fa.y = pk4f8(bflo(ra[rr].z), bfhi(ra[rr].z), bflo(ra[rr].w), bfhi(ra[rr].w), F8_XS);
                    fb.x = pk4f8(bflo(rb[rr].x), bfhi(rb[rr].x), bflo(rb[rr].y), bfhi(rb[rr].y), F8_XS); fb.y = pk4f8(bflo(rb[rr].z), bfhi(rb[rr].z), bflo(rb[rr].w), bfhi(rb[rr].w), F8_XS);
                    GAS v2u* e0 = (GAS v2u*)((unsigned char*)F.XG + (size_t)pos0 * D) + F.lane; GAS v2u* e1 = (GAS v2u*)((unsigned char*)F.XG + (size_t)pos1 * D) + F.lane;
                    e0[0] = fa; e0[64] = fb; e1[0] = fa; e1[64] = fb;
                } else {
                GAS v4u* d0 = (GAS v4u*)(F.XG + (size_t)pos0 * D) + F.lane; GAS v4u* d1 = (GAS v4u*)(F.XG + (size_t)pos1 * D) + F.lane;
                d0[0] = ra[rr]; d0[64] = rb[rr]; d1[0] = ra[rr]; d1[64] = rb[rr]; }
                if (F.lane == 0) TP[t] = (v2i){pos0, pos1}; }
        }
    }
    for (int i = F.bid * NWAVES + F.wave; i < NE * 256; i += F.G * NWAVES) {
        const int e = i >> 8, row = TOTL[8 + e] + TOTL[e] + (i & 255);
        if (row < TOTL[16 + e]) { if (MOE_GU_F8) { GAS v2u* d = (GAS v2u*)((unsigned char*)F.XG + (size_t)row * D) + F.lane; d[0] = (v2u){0u, 0u}; d[64] = (v2u){0u, 0u}; }
            else { GAS v4u* d = (GAS v4u*)(F.XG + (size_t)row * D) + F.lane; d[0] = (v4u){0u, 0u, 0u, 0u}; d[64] = (v4u){0u, 0u, 0u, 0u}; } }
    }
}

typedef short bf16x8 __attribute__((ext_vector_type(8)));
constexpr int ATT_KP = 144, ATT_VP = 272, ATT_KSLOT = 128 * ATT_KP, ATT_VSLOT = 64 * ATT_VP, ATT_VT_OFF = 3 * ATT_KSLOT, ATT_BIAS_OFF = ATT_VT_OFF + 3 * ATT_VSLOT;
constexpr int ATT_BT = 192, ATT_BT_OFF = 32;
static_assert(ATT_BIAS_OFF + 2 * ATT_BT * 4 <= RING_BYTES, "attention LDS map");
constexpr float LOG2E = 1.4426950408889634f, LN2 = 0.6931471805599453f;
constexpr int ATT_UNITS = NB * 8 * 96;
struct AttUnit { int b, h, p, d, r, n, chain; };
__device__ __forceinline__ AttUnit att_decode(int u) {
    AttUnit a; const int bh = u / 96, rem = u - bh * 96; a.p = rem >> 5; const int qq = rem & 31; a.b = bh >> 3; a.h = bh & 7;
    const int dsh = 2 * a.p, nbs = 5 - dsh; a.d = 1 << dsh; a.r = qq >> nbs; a.n = qq & ((1 << nbs) - 1); a.chain = u - a.n; return a;
}
__device__ __forceinline__ void att_load_block(const Frame& F, const AttUnit& a, int nblk, v4u (&kr)[2], v4u& va, v4u& vc) {
    const size_t seq0 = (size_t)a.b * SEQ;
#pragma unroll
    for (int k = 0; k < 2; ++k) { const int item = F.tid + NTHR * k, j = item >> 3, ch = item & 7;
        kr[k] = *(const GAS v4u*)(F.P + pix(seq0 + (size_t)(a.d * (128 * nblk + j) + a.r), C_AK + a.h * 64 + ch * 8)); }
    { const int kp = F.tid & 63, eo = F.tid >> 6; const size_t tok = seq0 + (size_t)(a.d * (128 * nblk + 2 * kp) + a.r);
      va = *(const GAS v4u*)(F.P + pix(tok, C_AV + a.h * 64 + eo * 8)); vc = *(const GAS v4u*)(F.P + pix(tok + a.d, C_AV + a.h * 64 + eo * 8)); }
}
__device__ __forceinline__ void att_store_block(const Frame& F, int slot, const v4u (&kr)[2], const v4u& a, const v4u& c) {
    LAS unsigned char* Ks = F.lds + slot * ATT_KSLOT; LAS unsigned char* Vt = F.lds + ATT_VT_OFF + slot * ATT_VSLOT;
#pragma unroll
    for (int k = 0; k < 2; ++k) { const int item = F.tid + NTHR * k, j = item >> 3, ch = item & 7; *(LAS v4u*)(Ks + j * ATT_KP + ch * 16) = kr[k]; }
    const int kp = F.tid & 63, eo = F.tid >> 6;
    LAS unsigned char* vb = Vt + (eo * 8) * ATT_VP + kp * 4;
    *(LAS unsigned*)(vb + 0 * ATT_VP) = (a.x & 0xffffu) | (c.x << 16); *(LAS unsigned*)(vb + 1 * ATT_VP) = (a.x >> 16) | (c.x & 0xffff0000u);
    *(LAS unsigned*)(vb + 2 * ATT_VP) = (a.y & 0xffffu) | (c.y << 16); *(LAS unsigned*)(vb + 3 * ATT_VP) = (a.y >> 16) | (c.y & 0xffff0000u);
    *(LAS unsigned*)(vb + 4 * ATT_VP) = (a.z & 0xffffu) | (c.z << 16); *(LAS unsigned*)(vb + 5 * ATT_VP) = (a.z >> 16) | (c.z & 0xffff0000u);
    *(LAS unsigned*)(vb + 6 * ATT_VP) = (a.w & 0xffffu) | (c.w << 16); *(LAS unsigned*)(vb + 7 * ATT_VP) = (a.w >> 16) | (c.w & 0xffff0000u);
}
__device__ __forceinline__ void att_compute(const Frame& F, const AttUnit& cu, size_t tq, bf16x8 bq0, bf16x8 bq1, bf16* OP, float* LSE, int sp, int sc, int bsel) {
    const LAS float* Bs = (const LAS float*)(F.lds + ATT_BIAS_OFF + bsel * ATT_BT * 4) + ATT_BT_OFF;
    const int lane = F.lane, w = F.wave, q = lane & 15, g = lane >> 4, i0 = 16 * w, n = cu.n;
    f32x4 o[4];
#pragma unroll
    for (int et = 0; et < 4; ++et) o[et] = zero4();
    float m = -1e30f, l = 0.f;
    const int c0 = w >> 1;
    for (int cc = 0; cc < 5; ++cc) {
        const int c = c0 + cc;
        if (n == 0 && c < 4) continue;
        const int slot = (c < 4) ? sp : sc, cl = c & 3;
        const LAS unsigned char* Ks = F.lds + slot * ATT_KSLOT; const LAS unsigned char* Vt = F.lds + ATT_VT_OFF + slot * ATT_VSLOT;
        bf16x8 ka[2][2], vf[4]; float bb[8];
        const int relb = i0 + q + 128 - (32 * c + 8 * g);
#pragma unroll
        for (int tt = 0; tt < 2; ++tt) { const int jrow = 32 * cl + 8 * (q >> 2) + 4 * tt + (q & 3);
            ka[tt][0] = *(const LAS bf16x8*)(Ks + jrow * ATT_KP + 16 * g); ka[tt][1] = *(const LAS bf16x8*)(Ks + jrow * ATT_KP + 64 + 16 * g); }
#pragma unroll
        for (int k = 0; k < 8; ++k) bb[k] = Bs[relb - k];
#pragma unroll
        for (int k = 0; k < 8; ++k) asm volatile("" : "+v"(bb[k]));
        __builtin_amdgcn_sched_barrier(0);
        f32x4 st[2];
#pragma unroll
        for (int tt = 0; tt < 2; ++tt) { f32x4 z = zero4();
            z = __builtin_amdgcn_mfma_f32_16x16x32_bf16(ka[tt][0], bq0, z, 0, 0, 0);
            st[tt] = __builtin_amdgcn_mfma_f32_16x16x32_bf16(ka[tt][1], bq1, z, 0, 0, 0); }
#pragma unroll
        for (int et = 0; et < 4; ++et) vf[et] = *(const LAS bf16x8*)(Vt + (16 * et + q) * ATT_VP + (32 * cl + 8 * g) * 2);
        float x[8]; float mx = -1e30f;
#pragma unroll
        for (int k = 0; k < 8; ++k) { const float v = st[k >> 2][k & 3] * (0.125f * LOG2E) + bb[k];
            x[k] = v; mx = fmaxf(mx, v); }
        mx = max_x4(mx);
        const float mn = fmaxf(m, mx), corr = __builtin_amdgcn_exp2f(m - mn); m = mn;
        float ps = 0.f;
#pragma unroll
        for (int k = 0; k < 8; ++k) { x[k] = __builtin_amdgcn_exp2f(x[k] - mn); ps += x[k]; }
        l = l * corr + ps;
#pragma unroll
        for (int et = 0; et < 4; ++et) o[et] = o[et] * corr;
        v4u pk; pk.x = pk2h(x[0], x[1]); pk.y = pk2h(x[2], x[3]); pk.z = pk2h(x[4], x[5]); pk.w = pk2h(x[6], x[7]);
        const bf16x8 pf = __builtin_bit_cast(bf16x8, pk);
#pragma unroll
        for (int et = 0; et < 4; ++et) o[et] = __builtin_amdgcn_mfma_f32_16x16x32_bf16(vf[et], pf, o[et], 0, 0, 0);
    }
    l = sum_x4(l);
    const float inv = __builtin_amdgcn_rcpf(l);
    bf16* orow = OP + ((size_t)cu.p * T + tq) * 512 + cu.h * 64 + 4 * g;
#pragma unroll
    for (int et = 0; et < 4; ++et) { v2u ov; ov.x = pk2h(o[et][0] * inv, o[et][1] * inv); ov.y = pk2h(o[et][2] * inv, o[et][3] * inv); *(GAS v2u*)(orow + 16 * et) = ov; }
    if (g == 0) LSE[((size_t)cu.p * T + tq) * 8 + cu.h] = (m + __builtin_amdgcn_logf(l)) * LN2;
}
struct AttSet { AttUnit u; v4u kr[2], va, vc; bf16x8 q0, q1; size_t tq; };
__device__ __forceinline__ void att_issue(const Frame& F, int u, AttSet& s) {
    s.u = att_decode(u); att_load_block(F, s.u, s.u.n, s.kr, s.va, s.vc);
    s.tq = (size_t)s.u.b * SEQ + (size_t)(s.u.d * (128 * s.u.n + 16 * F.wave + (F.lane & 15)) + s.u.r);
    const bf16* qp = F.P + pix(s.tq, C_AQ + s.u.h * 64 + 8 * (F.lane >> 4)); s.q0 = *(const GAS bf16x8*)qp; s.q1 = *(const GAS bf16x8*)(qp + 32);
}
__device__ __forceinline__ void ph_attn_mfma(Frame& F, bf16* OP, float* LSE) {
    const int upb = (ATT_UNITS + F.G - 1) / F.G, u0 = F.bid * upb, u1 = (u0 + upb < ATT_UNITS) ? u0 + upb : ATT_UNITS;
    if (u0 >= u1) return;
    AttSet cur, s1, s2;
    att_issue(F, u0, cur);
    att_store_block(F, 0, cur.kr, cur.va, cur.vc);
    if (cur.u.n > 0) { v4u kr[2], va, vc; att_load_block(F, cur.u, cur.u.n - 1, kr, va, vc); att_store_block(F, 2, kr, va, vc); }
    if (F.tid < ATT_BT) { const int rel = F.tid - ATT_BT_OFF; ((LAS float*)(F.lds + ATT_BIAS_OFF))[F.tid] = (rel >= 0 && rel <= 128) ? F.TAB[TAB_BIAS + (cur.u.p * 8 + cur.u.h) * 129 + rel] * LOG2E : -1e30f; }
    s1 = cur; s2 = cur;
    if (u0 + 1 < u1) att_issue(F, u0 + 1, s1);
    __syncthreads();
    int sc = 0, bsel = 0;
#define ATT_STEP(v, nxt, nxt2) { \
        if ((v) + 1 < u1) { att_store_block(F, (sc + 1) % 3, nxt.kr, nxt.va, nxt.vc); \
            if (F.tid < ATT_BT) { const int rel = F.tid - ATT_BT_OFF; ((LAS float*)(F.lds + ATT_BIAS_OFF + (bsel ^ 1) * ATT_BT * 4))[F.tid] = (rel >= 0 && rel <= 128) ? F.TAB[TAB_BIAS + (nxt.u.p * 8 + nxt.u.h) * 129 + rel] * LOG2E : -1e30f; } } \
        if ((v) + 2 < u1) att_issue(F, (v) + 2, nxt2); \
        att_compute(F, cur.u, cur.tq, cur.q0, cur.q1, OP, LSE, (sc + 2) % 3, sc, bsel); \
        __syncthreads(); \
        sc = (sc + 1) % 3; bsel ^= 1; \
        if ((v) + 1 < u1) { cur.u = nxt.u; cur.tq = nxt.tq; cur.q0 = nxt.q0; cur.q1 = nxt.q1; } }
    for (int u = u0; u < u1; u += 2) {
        ATT_STEP(u, s1, s2)
        if (u + 1 < u1) ATT_STEP(u + 1, s2, s1)
    }
#undef ATT_STEP
}
__device__ __forceinline__ void ph_attn_merge(Frame& F, const bf16* OP, const float* LSE) {
    const int wb = (F.G >= 256) ? F.bid - 128 : F.bid, nw = (F.G >= 256) ? F.G - 128 : F.G;
    if (wb < 0) return;
    const int stride = nw * NTHR;
    for (int i0 = wb * NTHR + F.tid; i0 < T * 64; i0 += 4 * stride) {
        float l0[4], l1[4], l2[4]; v4u a[4], b[4], c[4]; int idx[4]; bool ok[4];
#pragma unroll
        for (int k = 0; k < 4; ++k) { const int ii = i0 + k * stride; ok[k] = ii < T * 64; idx[k] = ok[k] ? ii : i0;
            const int t = idx[k] >> 6, h = (idx[k] >> 3) & 7, ec = idx[k] & 7; const size_t off = (size_t)t * 512 + h * 64 + ec * 8;
            l0[k] = LSE[(size_t)t * 8 + h]; l1[k] = LSE[((size_t)T + t) * 8 + h]; l2[k] = LSE[((size_t)2 * T + t) * 8 + h];
            a[k] = *(const GAS v4u*)(OP + off); b[k] = *(const GAS v4u*)(OP + (size_t)T * 512 + off); c[k] = *(const GAS v4u*)(OP + (size_t)2 * T * 512 + off); }
#pragma unroll
        for (int k = 0; k < 4; ++k) { PIN(l0[k]); PIN(l1[k]); PIN(l2[k]); PIN(a[k]); PIN(b[k]); PIN(c[k]); }
#pragma unroll
        for (int k = 0; k < 4; ++k) {
            const int t = idx[k] >> 6, h = (idx[k] >> 3) & 7, ec = idx[k] & 7;
            const float mx = fmaxf(l0[k], fmaxf(l1[k], l2[k])); float w0 = __expf(l0[k] - mx), w1 = __expf(l1[k] - mx), w2 = __expf(l2[k] - mx);
            const float iw = __builtin_amdgcn_rcpf(w0 + w1 + w2); w0 *= iw; w1 *= iw; w2 *= iw;
            v4u o;
            o.x = pk2(w0 * bflo(a[k].x) + w1 * bflo(b[k].x) + w2 * bflo(c[k].x), w0 * bfhi(a[k].x) + w1 * bfhi(b[k].x) + w2 * bfhi(c[k].x));
            o.y = pk2(w0 * bflo(a[k].y) + w1 * bflo(b[k].y) + w2 * bflo(c[k].y), w0 * bfhi(a[k].y) + w1 * bfhi(b[k].y) + w2 * bfhi(c[k].y));
            o.z = pk2(w0 * bflo(a[k].z) + w1 * bflo(b[k].z) + w2 * bflo(c[k].z), w0 * bfhi(a[k].z) + w1 * bfhi(b[k].z) + w2 * bfhi(c[k].z));
            o.w = pk2(w0 * bflo(a[k].w) + w1 * bflo(b[k].w) + w2 * bflo(c[k].w), w0 * bfhi(a[k].w) + w1 * bfhi(b[k].w) + w2 * bfhi(c[k].w));
            if (ok[k]) *(GAS v4u*)(F.Y + (size_t)t * D + 256 + h * 64 + ec * 8) = o; }
    }
}

constexpr int RWP = 144, RWU = 64 * RWP;
constexpr int U_AT = 0, U_BT = 1, U_KT = 2, U_RT = 3, U_BHT = 4, U_KHT = 5, U_VT = 6, U_CT0 = 7, U_P0 = 9, U_PT0 = 10, U_NRB = 11, U_X = 12;
constexpr int U_CT1 = 0, U_P1 = 2, U_PT1 = 12, U_MV = 9, U_EKT = 10;
constexpr int RW_LW = 9 * RWU, RW_AA = RW_LW + 16384, RW_SEG = 13 * RWU, RW_WL = RW_SEG + 2048;
static_assert(RW_AA + 16384 <= 13 * RWU && RW_WL + 768 + 8192 <= RING_BYTES && MISC_OFF + 1024 + 8192 <= LDS_BYTES, "rwkv LDS map");
constexpr size_t RWS_QEFF = 0, RWS_GP = 16 * MiB, RWS_HLOC = 32 * MiB, RWS_YLOC = 64 * MiB, RWS_BV = 96 * MiB, RWS_Z0T = 128 * MiB, RWS_BYTES = 144 * MiB;

__device__ __forceinline__ f32x4 gram_tile(const LAS unsigned char* A, int ra0, const LAS unsigned char* B, int rb0, int q, int g, f32x4 acc) {
    const LAS unsigned char* ap = A + (ra0 + q) * RWP + 16 * g; const LAS unsigned char* bp = B + (rb0 + q) * RWP + 16 * g;
    const bf16x8 a0 = *(const LAS bf16x8*)ap, a1 = *(const LAS bf16x8*)(ap + 64), b0 = *(const LAS bf16x8*)bp, b1 = *(const LAS bf16x8*)(bp + 64);
    acc = __builtin_amdgcn_mfma_f32_16x16x32_bf16(a0, b0, acc, 0, 0, 0);
    return __builtin_amdgcn_mfma_f32_16x16x32_bf16(a1, b1, acc, 0, 0, 0);
}
__device__ __forceinline__ void store_t(LAS unsigned char* OUT, int ra0, int rb0, int q, int g, f32x4 v) {
    v2u o; o.x = pk2(v[0], v[1]); o.y = pk2(v[2], v[3]); *(LAS v2u*)(OUT + (rb0 + q) * RWP + (ra0 + 4 * g) * 2) = o;
}
__device__ __forceinline__ f32x4 load_t(const LAS unsigned char* IN, int ra0, int rb0, int q, int g) {
    const v2u o = *(const LAS v2u*)(IN + (rb0 + q) * RWP + (ra0 + 4 * g) * 2); return (f32x4){bflo(o.x), bfhi(o.x), bflo(o.y), bfhi(o.y)};
}
__device__ __forceinline__ void load_mix8(const bf16* P, size_t tok, bool first, int col, const float* mu, float (&o)[8]) {
    const v4u c = *(const GAS v4u*)(P + pix(tok, col)); v4u pv = *(const GAS v4u*)(P + pix(first ? tok : tok - 1, col));
    if (first) pv = (v4u){0u, 0u, 0u, 0u};
    const f32x4 m0 = *(const GAS f32x4*)(mu + col), m1 = *(const GAS f32x4*)(mu + col + 4);
    o[0] = bflo(c.x) + (bflo(pv.x) - bflo(c.x)) * m0.x; o[1] = bfhi(c.x) + (bfhi(pv.x) - bfhi(c.x)) * m0.y;
    o[2] = bflo(c.y) + (bflo(pv.y) - bflo(c.y)) * m0.z; o[3] = bfhi(c.y) + (bfhi(pv.y) - bfhi(c.y)) * m0.w;
    o[4] = bflo(c.z) + (bflo(pv.z) - bflo(c.z)) * m1.x; o[5] = bfhi(c.z) + (bfhi(pv.z) - bfhi(c.z)) * m1.y;
    o[6] = bflo(c.w) + (bflo(pv.w) - bflo(c.w)) * m1.z; o[7] = bfhi(c.w) + (bfhi(pv.w) - bfhi(c.w)) * m1.w;
}
__device__ __forceinline__ bf16x8 pack8(const float (&x)[8]) { v4u p; p.x = pk2(x[0], x[1]); p.y = pk2(x[2], x[3]); p.z = pk2(x[4], x[5]); p.w = pk2(x[6], x[7]); return __builtin_bit_cast(bf16x8, p); }

__device__ __forceinline__ void r1_issue(const Frame& F, int ch, v4u (&dxc)[4], v4u (&dxp)[4], unsigned (&draw)[27]) {
    const int lane = F.lane, w = F.wave, q = lane & 15, g = lane >> 4;
    const int bh = ch >> 6, chunk = ch & 63, b = bh >> 2, h = bh & 3;
    const size_t tok0 = (size_t)b * SEQ + chunk * 64;
    { const int rt = w >> 1; const size_t tok = tok0 + 16 * rt + q; const bool first = (chunk == 0 && rt == 0 && q == 0);
#pragma unroll
      for (int i = 0; i < 4; ++i) { const int col = 768 + 32 * i + 8 * g; dxc[i] = *(const GAS v4u*)(F.P + pix(tok, col)); dxp[i] = *(const GAS v4u*)(F.P + pix(first ? tok : tok - 1, col)); } }
    { const int cg = h * 64 + lane; const size_t tokb = tok0 + 8 * w; const bool hasprev = !(chunk == 0 && w == 0);
      { const bf16* pp = F.P + pix(hasprev ? tokb - 1 : tokb, cg); draw[0] = pp[0]; draw[1] = pp[4 * PLANE]; draw[2] = pp[8 * PLANE]; }
#pragma unroll
      for (int j = 0; j < 8; ++j) { const bf16* pp = F.P + pix(tokb + j, cg); draw[3 * j + 3] = pp[0]; draw[3 * j + 4] = pp[4 * PLANE]; draw[3 * j + 5] = pp[8 * PLANE]; } }
}
__device__ __forceinline__ void r1_mix8(const v4u& c, const v4u& pv, const LAS float* mul, int col, float (&o)[8]) {
    const f32x4 m0 = *(const LAS f32x4*)(mul + col - 768), m1 = *(const LAS f32x4*)(mul + col - 768 + 4);
    o[0] = bflo(c.x) + (bflo(pv.x) - bflo(c.x)) * m0.x; o[1] = bfhi(c.x) + (bfhi(pv.x) - bfhi(c.x)) * m0.y;
    o[2] = bflo(c.y) + (bflo(pv.y) - bflo(c.y)) * m0.z; o[3] = bfhi(c.y) + (bfhi(pv.y) - bfhi(c.y)) * m0.w;
    o[4] = bflo(c.z) + (bflo(pv.z) - bflo(c.z)) * m1.x; o[5] = bfhi(c.z) + (bfhi(pv.z) - bfhi(c.z)) * m1.y;
    o[6] = bflo(c.w) + (bflo(pv.w) - bflo(c.w)) * m1.z; o[7] = bfhi(c.w) + (bfhi(pv.w) - bfhi(c.w)) * m1.w;
}
__device__ __forceinline__ void ph_rwkv_r1(Frame& F, int l, unsigned char* RWS) {
    LAS unsigned char* L = F.lds;
    const int lane = F.lane, w = F.wave, q = lane & 15, g = lane >> 4;
    const float* mu = F.mu + l * 1024;
    const bf16* WUPT = (const bf16*)(F.wsb + WS_TAB + TABB_WUPT); const bf16* AUPT = (const bf16*)(F.wsb + WS_TAB + TABB_AUPT);
    bf16* QEFF = (bf16*)(RWS + RWS_QEFF); bf16* GP = (bf16*)(RWS + RWS_GP); float* HLOC = (float*)(RWS + RWS_HLOC); float* YLOC = (float*)(RWS + RWS_YLOC); float* BV = (float*)(RWS + RWS_BV);
    LAS float* LW = (LAS float*)(L + RW_LW); LAS float* AA = (LAS float*)(L + RW_AA); LAS float* SEG = (LAS float*)(L + RW_SEG); LAS float* WL = (LAS float*)(L + RW_WL);
    if (F.bid >= NB * 4 * 64) return;
    LAS float* MUL = (LAS float*)(L + RW_WL + 256);
    if (F.tid < 128) MUL[F.tid] = mu[768 + F.tid];
    __syncthreads();
    int hcur = -1; float hw0[2] = {0.f, 0.f}, ha0[2] = {0.f, 0.f}, hmur = 0.f, hmuk = 0.f, hmuv = 0.f, hkk = 0.f, hka = 0.f, hrk = 0.f;
    LAS unsigned char* HW = L + RW_WL + 768;
    LAS unsigned char* HA = L + MISC_OFF + 1024;
    v4u pxc[4], pxp[4]; unsigned praw[27]; r1_issue(F, F.bid, pxc, pxp, praw);
    for (int ch = F.bid; ch < NB * 4 * 64; ch += F.G) {
        const int bh = ch >> 6, chunk = ch & 63, b = bh >> 2, h = bh & 3;
        const size_t tok0 = (size_t)b * SEQ + chunk * 64;
        v4u cxc[4], cxp[4]; unsigned raw[27];
#pragma unroll
        for (int i = 0; i < 4; ++i) { cxc[i] = pxc[i]; cxp[i] = pxp[i]; PIN(cxc[i]); PIN(cxp[i]); }
#pragma unroll
        for (int k = 0; k < 27; ++k) { raw[k] = praw[k]; PIN(raw[k]); }
        if (ch + F.G < NB * 4 * 64) r1_issue(F, ch + F.G, pxc, pxp, praw);
        if (h != hcur) { hcur = h;
            *(LAS v4u*)(HW + F.tid * 16) = *(const GAS v4u*)(WUPT + (size_t)(l * 4 + h) * 4096 + F.tid * 8); *(LAS v4u*)(HA + F.tid * 16) = *(const GAS v4u*)(AUPT + (size_t)(l * 4 + h) * 4096 + F.tid * 8);
#pragma unroll
            for (int k = 0; k < 2; ++k) { const int c = 16 * (2 * (w & 1) + k) + q; hw0[k] = F.w0[l * 256 + h * 64 + c]; ha0[k] = F.a0[l * 256 + h * 64 + c]; }
            { const int cg = h * 64 + lane; hmur = mu[cg]; hmuk = mu[256 + cg]; hmuv = mu[512 + cg]; hkk = F.k_k[l * 256 + cg]; hka = F.k_a[l * 256 + cg]; hrk = F.r_k[l * 256 + cg]; }
            __syncthreads(); }
        { const int rt = w >> 1; const bool first = (chunk == 0 && rt == 0 && q == 0);
          if (first) {
#pragma unroll
              for (int i = 0; i < 4; ++i) cxp[i] = (v4u){0u, 0u, 0u, 0u}; }
          float xw0[8], xw1[8], xa0[8], xa1[8];
          r1_mix8(cxc[0], cxp[0], MUL, 768 + 8 * g, xw0); r1_mix8(cxc[1], cxp[1], MUL, 800 + 8 * g, xw1);
          r1_mix8(cxc[2], cxp[2], MUL, 832 + 8 * g, xa0); r1_mix8(cxc[3], cxp[3], MUL, 864 + 8 * g, xa1);
#pragma unroll
          for (int i = 0; i < 8; ++i) { xw0[i] = 1.0f - 2.0f * __builtin_amdgcn_rcpf(__expf(2.0f * xw0[i]) + 1.0f); xw1[i] = 1.0f - 2.0f * __builtin_amdgcn_rcpf(__expf(2.0f * xw1[i]) + 1.0f); }
          const bf16x8 aw0 = pack8(xw0), aw1 = pack8(xw1), aa0 = pack8(xa0), aa1 = pack8(xa1);
#pragma unroll
          for (int k = 0; k < 2; ++k) { const int ct = 2 * (w & 1) + k, c = 16 * ct + q;
              const bf16x8 bw0 = *(const LAS bf16x8*)(HW + c * 128 + 16 * g), bw1 = *(const LAS bf16x8*)(HW + c * 128 + 64 + 16 * g), ba0 = *(const LAS bf16x8*)(HA + c * 128 + 16 * g), ba1 = *(const LAS bf16x8*)(HA + c * 128 + 64 + 16 * g);
              const float w0c_ = hw0[k], a0c_ = ha0[k];
              f32x4 dw = zero4(), da = zero4();
              dw = __builtin_amdgcn_mfma_f32_16x16x32_bf16(aw0, bw0, dw, 0, 0, 0); dw = __builtin_amdgcn_mfma_f32_16x16x32_bf16(aw1, bw1, dw, 0, 0, 0);
              da = __builtin_amdgcn_mfma_f32_16x16x32_bf16(aa0, ba0, da, 0, 0, 0); da = __builtin_amdgcn_mfma_f32_16x16x32_bf16(aa1, ba1, da, 0, 0, 0);
#pragma unroll
              for (int r = 0; r < 4; ++r) { const int t = 16 * rt + 4 * g + r; LW[t * 64 + c] = -0.6065306597126334f * sigm(w0c_ + dw[r]); AA[t * 64 + c] = sigm(a0c_ + da[r]); } } }
        __syncthreads();
        { const int c = lane, cg = h * 64 + c;
          const float mur = hmur, muk = hmuk, muv = hmuv;
          const float kkc = hkk, kac = hka, rkc = hrk;
          const bool hasprev = !(chunk == 0 && w == 0);
          float pr = hasprev ? bflo(raw[0]) : 0.f, pk = hasprev ? bflo(raw[1]) : 0.f, pv = hasprev ? bflo(raw[2]) : 0.f;
          float rr[8], kk2[8], vv[8], al[8], bb[8], cum[8], lws[8];
          float run = 0.f;
#pragma unroll
          for (int j = 0; j < 8; ++j) { const float cr = bflo(raw[3 * j + 3]), ck = bflo(raw[3 * j + 4]), cv = bflo(raw[3 * j + 5]);
              const float r_ = cr + (pr - cr) * mur, k_ = ck + (pk - ck) * muk, v_ = cv + (pv - cv) * muv; pr = cr; pk = ck; pv = cv;
              const int t = 8 * w + j; const float a_ = AA[t * 64 + c], lw = LW[t * 64 + c];
              const float kx = k_ * kkc, nn = wave_sum(kx * kx), kap = kx * __builtin_amdgcn_rsqf(fmaxf(nn, 1e-24f));
              const float kp = k_ * (1.0f + (a_ - 1.0f) * kac);
              const float bon = wave_sum(r_ * kp * rkc);
              rr[j] = r_; kk2[j] = kp; vv[j] = v_; al[j] = -kap; bb[j] = kap * a_; run += lw; cum[j] = run; lws[j] = lw;
              BV[(((size_t)ch * 16 + (w >> 1) * 4 + (c >> 4)) * 64 + (2 * (w & 1) + (j >> 2)) * 16 + (c & 15)) * 4 + (j & 3)] = bon * v_; }
          SEG[w * 64 + c] = run;
          __syncthreads();
          float off = 0.f, tot = 0.f;
#pragma unroll
          for (int ww = 0; ww < 8; ++ww) { const float s = SEG[ww * 64 + c]; tot += s; if (ww < w) off += s; }
          if (w == 0) WL[c] = __expf(tot);
          float at_[8], bt_[8], kt_[8], rt_[8], bh_[8], kh_[8];
#pragma unroll
          for (int j = 0; j < 8; ++j) { const float cu = off + cum[j], em = __expf(-cu), ep = __expf(cu), eh = __expf(tot - cu), epv = __expf(cu - lws[j]);
              at_[j] = al[j] * epv; bt_[j] = bb[j] * em; kt_[j] = kk2[j] * em; rt_[j] = rr[j] * ep; bh_[j] = bb[j] * eh; kh_[j] = kk2[j] * eh; }
#pragma unroll
          for (int j = 0; j < 8; ++j) { const int t = 8 * w + j;
              *(LAS bf16*)(L + U_AT * RWU + t * RWP + c * 2) = (bf16)f2bf(at_[j]); *(LAS bf16*)(L + U_BT * RWU + t * RWP + c * 2) = (bf16)f2bf(bt_[j]);
              *(LAS bf16*)(L + U_KT * RWU + t * RWP + c * 2) = (bf16)f2bf(kt_[j]); *(LAS bf16*)(L + U_RT * RWU + t * RWP + c * 2) = (bf16)f2bf(rt_[j]); }
          *(LAS bf16x8*)(L + U_CT0 * RWU + c * RWP + 16 * w) = pack8(at_);
          *(LAS bf16x8*)(L + U_BHT * RWU + c * RWP + 16 * w) = pack8(bh_);
          *(LAS bf16x8*)(L + U_KHT * RWU + c * RWP + 16 * w) = pack8(kh_);
          *(LAS bf16x8*)(L + U_VT * RWU + c * RWP + 16 * w) = pack8(vv); }
        __syncthreads();
        const int ra0 = 16 * (w >> 1);
#define RW_FRAG(f, unit, row0) { const LAS unsigned char* p_ = L + (unit) * RWU + ((row0) + q) * RWP + 16 * g; f[0] = *(const LAS bf16x8*)p_; f[1] = *(const LAS bf16x8*)(p_ + 64); }
#define RW_MM(acc, fa, fb) { acc = __builtin_amdgcn_mfma_f32_16x16x32_bf16(fa[0], fb[0], acc, 0, 0, 0); acc = __builtin_amdgcn_mfma_f32_16x16x32_bf16(fa[1], fb[1], acc, 0, 0, 0); }
        f32x4 nrk[2];
#pragma unroll
        for (int k = 0; k < 2; ++k) { const int rb0 = 16 * (2 * (w & 1) + k);
            bf16x8 fat[2], fbt[2], fkt[2], gb[2], ga[2], gk[2], gr[2];
            RW_FRAG(fat, U_AT, ra0) RW_FRAG(fbt, U_BT, ra0) RW_FRAG(fkt, U_KT, ra0)
            RW_FRAG(gb, U_BT, rb0) RW_FRAG(ga, U_AT, rb0) RW_FRAG(gk, U_KT, rb0)
            __builtin_amdgcn_sched_barrier(0);
            f32x4 d1 = zero4(), d2 = zero4(), d3 = zero4(), d4 = zero4(), d5 = zero4();
            RW_MM(d1, fat, gb)
            RW_MM(d2, fbt, ga)
            RW_MM(d3, fat, gk)
            RW_FRAG(gr, U_RT, rb0)
            RW_MM(d4, fbt, gr)
            RW_MM(d5, fkt, gr)
#pragma unroll
            for (int r = 0; r < 4; ++r) { const int row = ra0 + 4 * g + r, col = rb0 + q;
                if (!(col < row)) { d1[r] = 0.f; d3[r] = 0.f; } if (!(row < col)) d2[r] = 0.f; if (!(row <= col)) d4[r] = 0.f; }
            store_t(L + U_PT0 * RWU, ra0, rb0, q, g, d1); store_t(L + U_P0 * RWU, ra0, rb0, q, g, d2);
            store_t(L + (U_CT0 + 1) * RWU, ra0, rb0, q, g, d3); store_t(L + U_NRB * RWU, ra0, rb0, q, g, d4); nrk[k] = d5;
            __builtin_amdgcn_sched_barrier(0); }
        __syncthreads();
#pragma unroll
        for (int st = 0; st < 3; ++st) {
            const int uP = (st & 1) ? U_P1 : U_P0, uPT = (st & 1) ? U_PT1 : U_PT0, uC = (st & 1) ? U_CT1 : U_CT0;
            const int uPn = (st & 1) ? U_P0 : U_P1, uPTn = (st & 1) ? U_PT0 : U_PT1, uCn = (st & 1) ? U_CT0 : U_CT1;
            bf16x8 fp[2], fpt[2];
            RW_FRAG(fp, uP, ra0)
#pragma unroll
            for (int kk = 0; kk < 2; ++kk) { bf16x8 fc[2][2]; f32x4 add[2];
#pragma unroll
                for (int k = 0; k < 2; ++k) { const int rb0 = 16 * (4 * (w & 1) + 2 * kk + k); RW_FRAG(fc[k], uC, rb0) add[k] = load_t(L + uC * RWU, ra0, rb0, q, g); }
                __builtin_amdgcn_sched_barrier(0);
#pragma unroll
                for (int k = 0; k < 2; ++k) { const int rb0 = 16 * (4 * (w & 1) + 2 * kk + k); f32x4 d = add[k]; RW_MM(d, fp, fc[k]) store_t(L + uCn * RWU, ra0, rb0, q, g, d); }
                __builtin_amdgcn_sched_barrier(0); }
            if (st < 2) { bf16x8 gp[2][2], gpt[2][2];
                RW_FRAG(fpt, uPT, ra0)
#pragma unroll
                for (int k = 0; k < 2; ++k) { const int rb0 = 16 * (2 * (w & 1) + k); RW_FRAG(gpt[k], uPT, rb0) RW_FRAG(gp[k], uP, rb0) }
                __builtin_amdgcn_sched_barrier(0);
#pragma unroll
                for (int k = 0; k < 2; ++k) { const int rb0 = 16 * (2 * (w & 1) + k);
                    f32x4 e1 = zero4(), e2 = zero4();
                    RW_MM(e1, fp, gpt[k]) store_t(L + uPTn * RWU, ra0, rb0, q, g, e1);
                    RW_MM(e2, fpt, gp[k]) store_t(L + uPn * RWU, ra0, rb0, q, g, e2); } }
            __syncthreads();
        }
#pragma unroll
        for (int k = 0; k < 2; ++k) { const int rb0 = 16 * (2 * (w & 1) + k);
            bf16x8 fah[2], ftm[2], gn[2], gh[2];
            RW_FRAG(fah, U_CT1, ra0) RW_FRAG(ftm, U_CT1 + 1, ra0) RW_FRAG(gn, U_NRB, rb0) RW_FRAG(gh, U_BHT, rb0)
            const f32x4 ar = load_t(L + U_RT * RWU, ra0, rb0, q, g), ak = load_t(L + U_KHT * RWU, ra0, rb0, q, g); const float wl = WL[rb0 + q];
            __builtin_amdgcn_sched_barrier(0);
            { f32x4 d = ar; RW_MM(d, fah, gn)
              v2u o; o.x = pk2h(d[0], d[1]); o.y = pk2h(d[2], d[3]);
              *(GAS v2u*)(QEFF + (tok0 + rb0 + q) * 256 + h * 64 + ra0 + 4 * g) = o; }
            { f32x4 d = zero4(); RW_MM(d, fah, gh)
#pragma unroll
              for (int r = 0; r < 4; ++r) if (ra0 + 4 * g + r == rb0 + q) d[r] += wl;
              v2u o; o.x = pk2h(d[0], d[1]); o.y = pk2h(d[2], d[3]);
              const int tau = ra0 >> 4;
              *(GAS v2u*)(GP + ((size_t)ch * 64 + rb0 + q) * 64 + 32 * (tau >> 1) + 8 * g + 4 * (tau & 1)) = o; }
            { f32x4 d = nrk[k]; RW_MM(d, ftm, gn)
#pragma unroll
              for (int r = 0; r < 4; ++r) if (!(ra0 + 4 * g + r <= rb0 + q)) d[r] = 0.f;
              store_t(L + U_MV * RWU, ra0, rb0, q, g, d); }
            { f32x4 d = ak; RW_MM(d, ftm, gh)
              store_t(L + U_EKT * RWU, ra0, rb0, q, g, d); }
            __builtin_amdgcn_sched_barrier(0); }
        __syncthreads();
        { bf16x8 fmv[2], fek[2], gv[2][2];
          RW_FRAG(fmv, U_MV, ra0) RW_FRAG(fek, U_EKT, ra0)
#pragma unroll
          for (int k = 0; k < 2; ++k) { const int rb0 = 16 * (2 * (w & 1) + k); RW_FRAG(gv[k], U_VT, rb0) }
          __builtin_amdgcn_sched_barrier(0);
#pragma unroll
          for (int k = 0; k < 2; ++k) { const int ti = 2 * w + k;
              f32x4 y = zero4(), hh = zero4();
              RW_MM(y, fmv, gv[k]) *(GAS f32x4*)(YLOC + (((size_t)ch * 16 + ti) * 64 + lane) * 4) = y;
              RW_MM(hh, fek, gv[k]) *(GAS f32x4*)(HLOC + (((size_t)ch * 16 + ti) * 64 + lane) * 4) = hh; } }
#undef RW_FRAG
#undef RW_MM
        __syncthreads();
    }
}
__device__ __forceinline__ void ph_rwkv_r2(Frame& F, unsigned char* RWS) {
    const bf16* GP = (const bf16*)(RWS + RWS_GP); const float* HLOC = (const float*)(RWS + RWS_HLOC); bf16* Z0T = (bf16*)(RWS + RWS_Z0T);
    const int lane = F.lane, q = lane & 15, g = lane >> 4;
    constexpr int PD = 4;
    for (int task = F.bid + (F.wave ? 128 : 0); task < 128; task += F.G) {
        const int bh = task >> 2, ig = task & 3;
        f32x4 z[4];
#pragma unroll
        for (int t = 0; t < 4; ++t) z[t] = zero4();
        bf16x8 ga[PD][4][2]; f32x4 hl[PD][4];
        const bf16* gbase = GP + ((size_t)bh * 64 * 64 + q) * 64 + 8 * g; const float* hbase = HLOC + (((size_t)bh * 64 * 16 + ig) * 64 + lane) * 4;
#pragma unroll
        for (int k = 0; k < PD; ++k)
#pragma unroll
            for (int t = 0; t < 4; ++t) { const bf16* gp = gbase + ((size_t)k * 64 + 16 * t) * 64; ga[k][t][0] = *(const GAS bf16x8*)gp; ga[k][t][1] = *(const GAS bf16x8*)(gp + 32);
                hl[k][t] = *(const GAS f32x4*)(hbase + ((size_t)k * 16 + t * 4) * 256); }
        for (int c4 = 0; c4 < 64; c4 += PD) {
#pragma unroll
            for (int k = 0; k < PD; ++k) {
                const int chunk = c4 + k; const size_t ch = (size_t)bh * 64 + chunk;
                v2u pz[4];
#pragma unroll
                for (int t = 0; t < 4; ++t) { pz[t].x = pk2(z[t][0], z[t][1]); pz[t].y = pk2(z[t][2], z[t][3]); *(GAS v2u*)(Z0T + (ch * 64 + 16 * ig + q) * 64 + 16 * t + 4 * g) = pz[t]; }
                const bf16x8 b0 = __builtin_bit_cast(bf16x8, (v4u){pz[0].x, pz[0].y, pz[1].x, pz[1].y}), b1 = __builtin_bit_cast(bf16x8, (v4u){pz[2].x, pz[2].y, pz[3].x, pz[3].y});
#pragma unroll
                for (int t = 0; t < 4; ++t) { const f32x4 acc = __builtin_amdgcn_mfma_f32_16x16x32_bf16(ga[k][t][0], b0, hl[k][t], 0, 0, 0);
                    z[t] = __builtin_amdgcn_mfma_f32_16x16x32_bf16(ga[k][t][1], b1, acc, 0, 0, 0); }
                if (chunk + PD < 64) {
#pragma unroll
                    for (int t = 0; t < 4; ++t) { const bf16* gp = gbase + ((size_t)(chunk + PD) * 64 + 16 * t) * 64; ga[k][t][0] = *(const GAS bf16x8*)gp; ga[k][t][1] = *(const GAS bf16x8*)(gp + 32);
                        hl[k][t] = *(const GAS f32x4*)(hbase + ((size_t)(chunk + PD) * 16 + t * 4) * 256); } }
            }
        }
    }
}
__device__ __forceinline__ void ph_rwkv_r3(Frame& F, int l, unsigned char* RWS) {
    const bf16* QEFF = (const bf16*)(RWS + RWS_QEFF); const float* YLOC = (const float*)(RWS + RWS_YLOC); const float* BV = (const float*)(RWS + RWS_BV); const bf16* Z0T = (const bf16*)(RWS + RWS_Z0T);
    const bf16* GUPT = (const bf16*)(F.wsb + WS_TAB + TABB_GUPT);
    const float* mu = F.mu + l * 1024;
    const int lane = F.lane, q = lane & 15, g = lane >> 4;
    constexpr int R3_GP = 272, R3_MU = 64 * R3_GP, R3_LG = R3_MU + 512, R3_LB = R3_LG + 256;
    LAS unsigned char* GT = F.lds; LAS float* MU3 = (LAS float*)(F.lds + R3_MU); LAS float* LG = (LAS float*)(F.lds + R3_LG); LAS float* LB = (LAS float*)(F.lds + R3_LB);
    int hcur = -1;
    for (int task = F.bid * NWAVES + F.wave; task < NB * 4 * 64 * 4; task += F.G * NWAVES) {
        const int ch = task >> 2, rt = task & 3, bh = ch >> 6, chunk = ch & 63, b = bh >> 2, h = bh & 3;
        const size_t tok0 = (size_t)b * SEQ + chunk * 64 + 16 * rt;
        if (h != hcur) {
            if (hcur >= 0) __syncthreads();
            hcur = h;
#pragma unroll
            for (int i = 0; i < 2; ++i) { const int e = F.tid * 2 + i, c = e >> 4, part = e & 15;
                *(LAS v4u*)(GT + c * R3_GP + part * 16) = *(const GAS v4u*)(GUPT + ((size_t)(l * 4 + h) * 64 + c) * 128 + part * 8); }
            if (F.tid < 128) MU3[F.tid] = mu[896 + F.tid];
            if (F.tid < 64) { LG[F.tid] = F.rln_g[l * 256 + h * 64 + F.tid]; LB[F.tid] = F.rln_b[l * 256 + h * 64 + F.tid]; }
            __syncthreads(); }
        const bf16* qp = QEFF + (tok0 + q) * 256 + h * 64 + 8 * g;
        bf16x8 a0 = *(const GAS bf16x8*)qp, a1 = *(const GAS bf16x8*)(qp + 32);
        v4u xc[4], xp[4]; bf16x8 zb[4][2]; f32x4 yl[4], bvv[4];
        const bool first = (chunk == 0 && rt == 0 && q == 0);
#pragma unroll
        for (int s = 0; s < 4; ++s) { const int col = 896 + 32 * s + 8 * g; xc[s] = *(const GAS v4u*)(F.P + pix(tok0 + q, col)); xp[s] = *(const GAS v4u*)(F.P + pix(first ? tok0 + q : tok0 + q - 1, col)); }
#pragma unroll
        for (int ct = 0; ct < 4; ++ct) { const bf16* zp = Z0T + ((size_t)ch * 64 + 16 * ct + q) * 64 + 8 * g; zb[ct][0] = *(const GAS bf16x8*)zp; zb[ct][1] = *(const GAS bf16x8*)(zp + 32);
            yl[ct] = *(const GAS f32x4*)(YLOC + (((size_t)ch * 16 + rt * 4 + ct) * 64 + lane) * 4);
            bvv[ct] = *(const GAS f32x4*)(BV + (((size_t)ch * 16 + rt * 4 + ct) * 64 + lane) * 4); }
        PIN(a0); PIN(a1);
#pragma unroll
        for (int s = 0; s < 4; ++s) { PIN(xc[s]); PIN(xp[s]); if (first) xp[s] = (v4u){0u, 0u, 0u, 0u}; }
#pragma unroll
        for (int ct = 0; ct < 4; ++ct) { PIN(zb[ct][0]); PIN(zb[ct][1]); PIN(yl[ct]); PIN(bvv[ct]); }
        bf16x8 ag[4];
#pragma unroll
        for (int s = 0; s < 4; ++s) { float xg[8]; const f32x4 m0 = *(const LAS f32x4*)(MU3 + 32 * s + 8 * g), m1 = *(const LAS f32x4*)(MU3 + 32 * s + 8 * g + 4);
            xg[0] = bflo(xc[s].x) + (bflo(xp[s].x) - bflo(xc[s].x)) * m0.x; xg[1] = bfhi(xc[s].x) + (bfhi(xp[s].x) - bfhi(xc[s].x)) * m0.y;
            xg[2] = bflo(xc[s].y) + (bflo(xp[s].y) - bflo(xc[s].y)) * m0.z; xg[3] = bfhi(xc[s].y) + (bfhi(xp[s].y) - bfhi(xc[s].y)) * m0.w;
            xg[4] = bflo(xc[s].z) + (bflo(xp[s].z) - bflo(xc[s].z)) * m1.x; xg[5] = bfhi(xc[s].z) + (bfhi(xp[s].z) - bfhi(xc[s].z)) * m1.y;
            xg[6] = bflo(xc[s].w) + (bflo(xp[s].w) - bflo(xc[s].w)) * m1.z; xg[7] = bfhi(xc[s].w) + (bfhi(xp[s].w) - bfhi(xc[s].w)) * m1.w;
#pragma unroll
            for (int i = 0; i < 8; ++i) xg[i] = sigm(xg[i]);
            ag[s] = pack8(xg); }
        f32x4 y[4], gt[4];
#pragma unroll
        for (int ct = 0; ct < 4; ++ct) {
            bf16x8 gb[4];
#pragma unroll
            for (int s = 0; s < 4; ++s) gb[s] = *(const LAS bf16x8*)(GT + (16 * ct + q) * R3_GP + (32 * s + 8 * g) * 2);
            f32x4 acc = __builtin_amdgcn_mfma_f32_16x16x32_bf16(a0, zb[ct][0], yl[ct], 0, 0, 0);
            y[ct] = __builtin_amdgcn_mfma_f32_16x16x32_bf16(a1, zb[ct][1], acc, 0, 0, 0);
            f32x4 ga = zero4();
#pragma unroll
            for (int s = 0; s < 4; ++s) ga = __builtin_amdgcn_mfma_f32_16x16x32_bf16(ag[s], gb[s], ga, 0, 0, 0);
            gt[ct] = ga; }
#pragma unroll
        for (int r = 0; r < 4; ++r) {
            float s = (y[0][r] + y[1][r]) + (y[2][r] + y[3][r]);
            s = sum16(s);
            const float mean = s * (1.0f / 64.0f);
            float v = 0.f;
#pragma unroll
            for (int ct = 0; ct < 4; ++ct) { const float dd = y[ct][r] - mean; y[ct][r] = dd; v += dd * dd; }
            v = sum16(v);
            const float rs = __builtin_amdgcn_rsqf(v * (1.0f / 64.0f) + 64e-5f);
#pragma unroll
            for (int ct = 0; ct < 4; ++ct) y[ct][r] *= rs; }
#pragma unroll
        for (int ct = 0; ct < 4; ++ct) { const int cg = h * 64 + 16 * ct + q; const float lg = LG[16 * ct + q], lb = LB[16 * ct + q];
            const f32x4 bv = bvv[ct];
#pragma unroll
            for (int r = 0; r < 4; ++r) { const float o = (y[ct][r] * lg + lb + bv[r]) * gt[ct][r];
                F.Y[(tok0 + 4 * g + r) * D + cg] = (bf16)f2bf(o); } }
    }
    __syncthreads();
}

constexpr size_t RTS_QG = 0, RTS_KG = 16 * MiB, RTS_VTG = 32 * MiB, RTS_HLOC = 48 * MiB, RTS_Z0T = 80 * MiB, RTS_BYTES = 96 * MiB;
__device__ __forceinline__ float ret_loggamma(int h) { return __logf(1.0f - exp2f(-5.0f - (float)h)); }
__device__ __forceinline__ void ph_ret_c1(Frame& F, unsigned char* RTS) {
    LAS unsigned char* L = F.lds;
    bf16* QG = (bf16*)(RTS + RTS_QG); bf16* KG = (bf16*)(RTS + RTS_KG); bf16* VTG = (bf16*)(RTS + RTS_VTG); float* HLOC = (float*)(RTS + RTS_HLOC);
    const int lane = F.lane, w = F.wave, q = lane & 15, g = lane >> 4;
    unsigned praw[24]; float pcsn[16];
#define C1_ISSUE(chx) { const int bh_ = (chx) >> 6, chunk_ = (chx) & 63, b_ = bh_ >> 2, h_ = bh_ & 3; const size_t tk_ = (size_t)b_ * SEQ + chunk_ * 64; const int cg_ = h_ * 64 + lane, fi_ = lane & 31; \
        _Pragma("unroll") for (int j = 0; j < 8; ++j) { const int t = 8 * w + j, pos = chunk_ * 64 + t; const bf16* pp = F.P + pix(tk_ + t, C_RQ + cg_); \
            praw[3 * j] = pp[0]; praw[3 * j + 1] = pp[4 * PLANE]; praw[3 * j + 2] = pp[8 * PLANE]; \
            pcsn[2 * j] = F.TAB[TAB_COS + pos * 32 + fi_]; pcsn[2 * j + 1] = F.TAB[TAB_SIN + pos * 32 + fi_]; } }
    if (F.bid < NB * 4 * 64) C1_ISSUE(F.bid)
    for (int ch = F.bid; ch < NB * 4 * 64; ch += F.G) {
        const int bh = ch >> 6, chunk = ch & 63, b = bh >> 2, h = bh & 3;
        const size_t tok0 = (size_t)b * SEQ + chunk * 64;
        const float lgm = ret_loggamma(h);
        { const int c = lane, cg = h * 64 + c;
          float kg[8], vv[8];
          unsigned raw[24]; float csn[16];
#pragma unroll
          for (int k = 0; k < 24; ++k) { raw[k] = praw[k]; PIN(raw[k]); }
#pragma unroll
          for (int k = 0; k < 16; ++k) { csn[k] = pcsn[k]; PIN(csn[k]); }
          { const int chn = (ch + F.G < NB * 4 * 64) ? ch + F.G : ch; C1_ISSUE(chn) }
#pragma unroll
          for (int j = 0; j < 8; ++j) { const int t = 8 * w + j;
              const float qc = bflo(raw[3 * j]), kc = bflo(raw[3 * j + 1]); vv[j] = bflo(raw[3 * j + 2]);
              const float cs = csn[2 * j], sn = csn[2 * j + 1];
              const float qo = xor32(qc, c), ko = xor32(kc, c);
              const float qr = (c < 32) ? (qc * cs - qo * sn) : (qo * sn + qc * cs);
              const float kr = (c < 32) ? (kc * cs - ko * sn) : (ko * sn + kc * cs);
              const float qgv = qr * __expf(lgm * (float)t); kg[j] = kr * 0.125f * __expf(-lgm * (float)t);
              QG[(tok0 + t) * 256 + cg] = (bf16)f2bf(qgv); KG[(tok0 + t) * 256 + cg] = (bf16)f2bf(kg[j]); }
          const bf16x8 kp = pack8(kg), vp = pack8(vv);
          *(LAS bf16x8*)(L + 0 * RWU + c * RWP + 16 * w) = kp; *(LAS bf16x8*)(L + 1 * RWU + c * RWP + 16 * w) = vp;
          *(GAS bf16x8*)(VTG + ((size_t)ch * 64 + c) * 64 + 8 * w) = vp; }
        __syncthreads();
        const float g63 = __expf(lgm * 63.0f);
#pragma unroll
        for (int k = 0; k < 2; ++k) { const int ti = 2 * w + k, ra0 = 16 * (ti >> 2), rb0 = 16 * (ti & 3);
            f32x4 d = gram_tile(L + 0 * RWU, ra0, L + 1 * RWU, rb0, q, g, zero4());
            *(GAS f32x4*)(HLOC + (((size_t)ch * 16 + ti) * 64 + lane) * 4) = d * g63; }
        __syncthreads();
    }
#undef C1_ISSUE
}
__device__ __forceinline__ void ph_ret_c2(Frame& F, unsigned char* RTS, int blk0) {
    const float* HLOC = (const float*)(RTS + RTS_HLOC); bf16* Z0T = (bf16*)(RTS + RTS_Z0T);
    const int lane = F.lane, q = lane & 15, g = lane >> 4;
    for (int task = (F.bid - blk0) * NWAVES + F.wave; task >= 0 && task < 32 * 16; task += F.G * NWAVES) {
        const int bh = task >> 4, ti = task & 15, td = ti >> 2, te = ti & 3, h = bh & 3;
        const float g64 = __expf(ret_loggamma(h) * 64.0f);
        f32x4 z = zero4();
        const float* hb = HLOC + ((((size_t)bh * 64) * 16 + ti) * 64 + lane) * 4;
        f32x4 hn[16];
#pragma unroll
        for (int k = 0; k < 16; ++k) hn[k] = *(const GAS f32x4*)(hb + (size_t)k * 4096);
        for (int c16 = 0; c16 < 64; c16 += 16) {
            f32x4 hc[16];
#pragma unroll
            for (int k = 0; k < 16; ++k) hc[k] = hn[k];
            if (c16 + 16 < 64) {
#pragma unroll
                for (int k = 0; k < 16; ++k) hn[k] = *(const GAS f32x4*)(hb + (size_t)(c16 + 16 + k) * 4096); }
#pragma unroll
            for (int k = 0; k < 16; ++k) { const size_t ch = (size_t)bh * 64 + c16 + k;
                v2u o; o.x = pk2(z[0], z[1]); o.y = pk2(z[2], z[3]);
                *(GAS v2u*)(Z0T + (ch * 64 + 16 * te + q) * 64 + 16 * td + 4 * g) = o;
                z = z * g64 + hc[k]; }
        }
    }
}
__device__ __forceinline__ void ph_ret_c3(Frame& F, int l, unsigned char* RTS) {
    const bf16* QG = (const bf16*)(RTS + RTS_QG); const bf16* KG = (const bf16*)(RTS + RTS_KG); const bf16* VTG = (const bf16*)(RTS + RTS_VTG); const bf16* Z0T = (const bf16*)(RTS + RTS_Z0T);
    const int lane = F.lane, q = lane & 15, g = lane >> 4;
    LAS unsigned char* Sc = F.lds + F.wave * 2304;
    int hcur = -1; float hgg[4] = {0.f, 0.f, 0.f, 0.f}, hgb[4] = {0.f, 0.f, 0.f, 0.f};
    for (int task = F.bid * NWAVES + F.wave; task < NB * 4 * 64 * 4; task += F.G * NWAVES) {
        const int ch = task >> 2, rt = task & 3, bh = ch >> 6, chunk = ch & 63, b = bh >> 2, h = bh & 3;
        if (h != hcur) { hcur = h;
#pragma unroll
            for (int ct = 0; ct < 4; ++ct) { hgg[ct] = F.gn_g[l * 256 + h * 64 + 16 * ct + q]; hgb[ct] = F.gn_b[l * 256 + h * 64 + 16 * ct + q]; } }
        const size_t tokc = (size_t)b * SEQ + chunk * 64;
        const float gam = 1.0f - exp2f(-5.0f - (float)h);
        const bf16* qp = QG + (tokc + 16 * rt + q) * 256 + h * 64 + 8 * g;
        bf16x8 q0 = *(const GAS bf16x8*)qp, q1 = *(const GAS bf16x8*)(qp + 32);
        bf16x8 kf[4][2];
#pragma unroll
        for (int st = 0; st < 4; ++st) { const bf16* kp = KG + (tokc + 16 * st + q) * 256 + h * 64 + 8 * g; kf[st][0] = *(const GAS bf16x8*)kp; kf[st][1] = *(const GAS bf16x8*)(kp + 32); }
        unsigned graw[16];
#pragma unroll
        for (int ct = 0; ct < 4; ++ct)
#pragma unroll
            for (int r = 0; r < 4; ++r) graw[ct * 4 + r] = F.P[pix(tokc + 16 * rt + 4 * g + r, C_RG + h * 64 + 16 * ct + q)];
        bf16x8 zf[4][2], vf[4][2];
#pragma unroll
        for (int ct = 0; ct < 4; ++ct) { const bf16* zp = Z0T + ((size_t)ch * 64 + 16 * ct + q) * 64 + 8 * g; zf[ct][0] = *(const GAS bf16x8*)zp; zf[ct][1] = *(const GAS bf16x8*)(zp + 32);
            const bf16* vp = VTG + ((size_t)ch * 64 + 16 * ct + q) * 64 + 8 * g; vf[ct][0] = *(const GAS bf16x8*)vp; vf[ct][1] = *(const GAS bf16x8*)(vp + 32); }
        PIN(q0); PIN(q1);
#pragma unroll
        for (int st = 0; st < 4; ++st) { PIN(kf[st][0]); PIN(kf[st][1]); }
#pragma unroll
        for (int st = 0; st < 4; ++st) {
            f32x4 d = zero4();
            d = __builtin_amdgcn_mfma_f32_16x16x32_bf16(kf[st][0], q0, d, 0, 0, 0); d = __builtin_amdgcn_mfma_f32_16x16x32_bf16(kf[st][1], q1, d, 0, 0, 0);
#pragma unroll
            for (int r = 0; r < 4; ++r) if (!(16 * st + 4 * g + r <= 16 * rt + q)) d[r] = 0.f;
            v2u o; o.x = pk2h(d[0], d[1]); o.y = pk2h(d[2], d[3]);
            *(LAS v2u*)(Sc + q * RWP + (16 * st + 4 * g) * 2) = o; }
        asm volatile("s_waitcnt lgkmcnt(0)" ::: "memory");
        const bf16x8 s0 = *(const LAS bf16x8*)(Sc + q * RWP + 16 * g), s1 = *(const LAS bf16x8*)(Sc + q * RWP + 64 + 16 * g);
        asm volatile("" ::: "memory");
#pragma unroll
        for (int ct = 0; ct < 4; ++ct) { PIN(zf[ct][0]); PIN(zf[ct][1]); PIN(vf[ct][0]); PIN(vf[ct][1]); }
#pragma unroll
        for (int k = 0; k < 16; ++k) PIN(graw[k]);
        f32x4 y[4];
#pragma unroll
        for (int ct = 0; ct < 4; ++ct) {
            f32x4 acc = zero4();
            acc = __builtin_amdgcn_mfma_f32_16x16x32_bf16(q0, zf[ct][0], acc, 0, 0, 0);
            acc = __builtin_amdgcn_mfma_f32_16x16x32_bf16(q1, zf[ct][1], acc, 0, 0, 0);
            acc = acc * gam;
            acc = __builtin_amdgcn_mfma_f32_16x16x32_bf16(s0, vf[ct][0], acc, 0, 0, 0);
            acc = __builtin_amdgcn_mfma_f32_16x16x32_bf16(s1, vf[ct][1], acc, 0, 0, 0);
            y[ct] = acc; }
#pragma unroll
        for (int r = 0; r < 4; ++r) {
            float s = (y[0][r] + y[1][r]) + (y[2][r] + y[3][r]);
            s = sum16(s);
            const float mean = s * (1.0f / 64.0f);
            float v = 0.f;
#pragma unroll
            for (int ct = 0; ct < 4; ++ct) { const float dd = y[ct][r] - mean; y[ct][r] = dd; v += dd * dd; }
            v = sum16(v);
            const float rs = __builtin_amdgcn_rsqf(v * (1.0f / 64.0f) + LN_EPS);
#pragma unroll
            for (int ct = 0; ct < 4; ++ct) y[ct][r] *= rs; }
#pragma unroll
        for (int ct = 0; ct < 4; ++ct) { const int cg = h * 64 + 16 * ct + q; const float gg = hgg[ct], gb = hgb[ct];
#pragma unroll
            for (int r = 0; r < 4; ++r) { const size_t tok = tokc + 16 * rt + 4 * g + r; const float ge = bflo(graw[ct * 4 + r]);
                F.Y[tok * D + 768 + cg] = (bf16)f2bf(ge * sigm(ge) * (y[ct][r] * gg + gb)); } }
    }
}

#ifndef REP_MIX
#define REP_MIX 1
#endif
#ifndef REP_GEMM
#define REP_GEMM 1
#endif
#ifndef REP_LNX
#define REP_LNX 1
#endif
#ifndef WGM_WIDE
#define WGM_WIDE 4
#endif
#ifndef WGM_MGU
#define WGM_MGU 4
#endif
#ifndef WGM_N1K
#define WGM_N1K 4
#endif
#ifndef REP_MDN
#define REP_MDN 1
#endif
#ifndef REP_MGU
#define REP_MGU 1
#endif
#ifndef REP_INP
#define REP_INP 1
#endif
#ifndef REP_OUTP
#define REP_OUTP 1
#endif
#ifndef REP_BAR
#define REP_BAR 1
#endif
#ifndef REP_PRO
#define REP_PRO 1
#endif
#ifndef REP_GATH
#define REP_GATH 1
#endif
#ifndef REP_R1
#define REP_R1 1
#endif
#ifndef REP_C1
#define REP_C1 1
#endif
#ifndef REP_ATT
#define REP_ATT 1
#endif
#ifndef ATT_PROBE_MODE
#define ATT_PROBE_MODE 0
#endif
#ifndef REP_S2
#define REP_S2 1
#endif
#ifndef REP_R3
#define REP_R3 1
#endif
#ifndef REP_C3
#define REP_C3 1
#endif
struct Args { const float* in[26]; float* out; unsigned char* ws; int ph_lo, ph_hi; };
constexpr int N_PHASES = 1 + 2 * 9 + 2 * 10;

typedef const __attribute__((address_space(4))) Args* KArgs;
__device__ __forceinline__ void mk_frame(Frame& F, LAS unsigned char* lds) {
    KArgs ka = (KArgs)__builtin_amdgcn_kernarg_segment_ptr(); asm volatile("" : "+s"(ka));
    F.lds = lds; F.MISC = (volatile LAS unsigned*)(lds + MISC_OFF);
    { int t_ = threadIdx.x; asm volatile("" : "+v"(t_)); F.tid = t_; }
    { int b_ = blockIdx.x; asm volatile("" : "+s"(b_)); F.bid = b_; }
    F.lane = F.tid & 63; F.wave = __builtin_amdgcn_readfirstlane(F.tid >> 6); F.G = gridDim.x;
    F.lo = ka->ph_lo; F.hi = ka->ph_hi;
    unsigned char* ws = ka->ws; F.wsb = ws;
    F.ctl = (gu32*)(ws + WS_CTL);
    F.x = ka->in[0]; F.w_in = ka->in[1]; F.w_out = ka->in[2]; F.mu = ka->in[3]; F.w0 = ka->in[4]; F.w_up = ka->in[5]; F.a0 = ka->in[6]; F.a_up = ka->in[7]; F.g_up = ka->in[8];
    F.k_k = ka->in[9]; F.k_a = ka->in[10]; F.r_k = ka->in[11]; F.rln_g = ka->in[12]; F.rln_b = ka->in[13]; F.gn_g = ka->in[14]; F.gn_b = ka->in[15]; F.rel_bias = ka->in[16];
    F.ln_g = ka->in[17]; F.ln_b = ka->in[18]; F.ffn_g = ka->in[19]; F.ffn_u = ka->in[20]; F.ffn_d = ka->in[21]; F.router = ka->in[22]; F.moe_g = ka->in[23]; F.moe_u = ka->in[24]; F.moe_d = ka->in[25];
    F.out = ka->out;
    F.TAB = (float*)(ws + WS_TAB);
    F.WIN_T = (bf16*)(ws + WS_WIN); F.WOUT_T = (bf16*)(ws + WS_WOUT); F.WGU_T = (bf16*)(ws + WS_WGU); F.WD_T = (bf16*)(ws + WS_WD); F.WGUE = (bf16*)(ws + WS_WGUE); F.WDE = (bf16*)(ws + WS_WDE);
    F.XB = (bf16*)(ws + WS_XB); F.P = (bf16*)(ws + WS_SH + SH_P); F.Y = (bf16*)(ws + WS_SH + SH_Y);
    F.HB = (bf16*)(ws + WS_SH + SH_H); F.HID = (bf16*)(ws + WS_SH + SH_HID); F.HIDM = (bf16*)(ws + WS_SH + SH_HIDM); F.XG = (bf16*)(ws + WS_SH + SH_XG); F.TOK = ws + WS_SH + SH_TOK;
}

__global__ void __launch_bounds__(NTHR, 2) fwd_kernel(Args args) {
    extern __shared__ __attribute__((aligned(16))) unsigned char lds[];
    const int tid0 = threadIdx.x;
    for (int u = tid0; u < (LDS_BYTES - LDSCTL_OFF) / 4; u += NTHR) ((LAS unsigned*)((LAS unsigned char*)lds + LDSCTL_OFF))[u] = 0u;
    __syncthreads();
    if (args.ph_hi - args.ph_lo > 1) (void)xcd_barrier_post((unsigned*)(args.ws + WS_CTL) + CW_BAR, (volatile LAS unsigned*)((LAS unsigned char*)lds + MISC_OFF) + 8);
#define PH_BEGIN_R(phx, reps) { KArgs ka_ = (KArgs)__builtin_amdgcn_kernarg_segment_ptr(); asm volatile("" : "+s"(ka_)); const int lo_ = ka_->ph_lo, hi_ = ka_->ph_hi, ph = (phx); if (ph >= lo_ && ph < hi_) { \
    _Pragma("unroll 1") for (int rep_ = 0; rep_ < (reps); ++rep_) { Frame F; mk_frame(F, (LAS unsigned char*)lds);
#define PH_BEGIN(phx) PH_BEGIN_R(phx, 1)
#define PH_BEGIN_G(phx) PH_BEGIN_R(phx, REP_GEMM)
#define PH_BEGIN_M(phx) PH_BEGIN_R(phx, REP_MIX)
#define PH_END   } if (ph + 1 < hi_) { KArgs kb_ = (KArgs)__builtin_amdgcn_kernarg_segment_ptr(); asm volatile("" : "+s"(kb_)); XcdBarrier b_; b_.bar = (unsigned*)(kb_->ws + WS_CTL) + CW_BAR; b_.x = xb_xcc_id(); \
        b_.st = (volatile LAS unsigned*)((LAS unsigned char*)lds + MISC_OFF) + 8; _Pragma("unroll 1") for (int rb_ = 0; rb_ < REP_BAR; ++rb_) xcd_barrier(b_); } } }

    PH_BEGIN_R(0, REP_PRO) ph_prologue(F); PH_END

    for (int l = 0; l < DEPTH; ++l) {
        const int jj = l >> 1; const bool moe = (l & 1) != 0; const int pb = 1 + jj * 19 + (l & 1) * 9;
        PH_BEGIN_R(pb + 0, REP_GEMM * REP_INP)
            pg8::Gemm g{F.XB, F.WIN_T + (size_t)l * NIN * D, T, NIN, D}; pg8::StaticOrder S; S.init(T, NIN, F.G, F.bid, WGM_WIDE);
            pg8::EpiPlane E{F.P};
            pg8::gemm_phase<pg8::EpiPlane, pg8::StaticOrder, true, true>(F.lds + RING_OFF, g, S, E);
        PH_END
        PH_BEGIN_M(pb + 1)
            if (l == 3) { convert_moe(F, 1); __syncthreads(); }
_Pragma("unroll 1") for (int r_ = 0; r_ < REP_R1; ++r_) { Frame F2; mk_frame(F2, (LAS unsigned char*)lds); ph_rwkv_r1(F2, l, F2.wsb + WS_SH + SH_RWS); }
_Pragma("unroll 1") for (int r_ = 0; r_ < REP_C1; ++r_) { Frame F2; mk_frame(F2, (LAS unsigned char*)lds); ph_ret_c1(F2, F2.wsb + WS_SH + SH_RTS); }
_Pragma("unroll 1") for (int r_ = 0; r_ < REP_ATT; ++r_) { Frame F2; mk_frame(F2, (LAS unsigned char*)lds); ph_attn_mfma(F2, (bf16*)(F2.wsb + WS_SH + SH_OP), (float*)(F2.wsb + WS_SH + SH_LSE)); }
        PH_END
        PH_BEGIN_M(pb + 2)
_Pragma("unroll 1") for (int r_ = 0; r_ < REP_S2; ++r_) { Frame F2; mk_frame(F2, (LAS unsigned char*)lds);
            ph_rwkv_r2(F2, F2.wsb + WS_SH + SH_RWS);
            ph_ret_c2(F2, F2.wsb + WS_SH + SH_RTS, 128);
            ph_attn_merge(F2, (const bf16*)(F2.wsb + WS_SH + SH_OP), (const float*)(F2.wsb + WS_SH + SH_LSE)); }
        PH_END
        PH_BEGIN_M(pb + 3)
_Pragma("unroll 1") for (int r_ = 0; r_ < REP_R3; ++r_) { Frame F2; mk_frame(F2, (LAS unsigned char*)lds); ph_rwkv_r3(F2, l, F2.wsb + WS_SH + SH_RWS); }
_Pragma("unroll 1") for (int r_ = 0; r_ < REP_C3; ++r_) { Frame F2; mk_frame(F2, (LAS unsigned char*)lds); ph_ret_c3(F2, l, F2.wsb + WS_SH + SH_RTS); }
        PH_END
        PH_BEGIN_R(pb + 4, REP_GEMM * REP_OUTP)
            pg8::Gemm g{F.Y, F.WOUT_T + (size_t)l * D * D, T, D, D}; pg8::StaticOrder S; S.init(T, D, F.G, F.bid, WGM_N1K);
            pg8::EpiBf16<0> E{F.HB, D, nullptr, 0, 0, 1.f};
            pg8::gemm_phase<pg8::EpiBf16<0>, pg8::StaticOrder, true, true>(F.lds + RING_OFF, g, S, E);
        PH_END
        PH_BEGIN_R(pb + 5, REP_LNX)
            if (moe) ph_ln<1, false>(F, nullptr, nullptr, F.ln_g + (size_t)(l * 2) * D, F.ln_b + (size_t)(l * 2) * D, F.router + (size_t)jj * D * NE, rep_ ? (bf16*)(F.wsb + WS_SH + SH_OP) : F.XB, rep_ > 0);
            else if (l == 0) ph_ln<0, true>(F, F.x, nullptr, F.ln_g + (size_t)(l * 2) * D, F.ln_b + (size_t)(l * 2) * D, nullptr, rep_ ? (bf16*)(F.wsb + WS_SH + SH_OP) : F.XB, rep_ > 0, 0x7fffffff, nullptr, 0, DENSE_F8 ? (unsigned char*)F.XG : nullptr);
            else ph_ln<0, false>(F, nullptr, nullptr, F.ln_g + (size_t)(l * 2) * D, F.ln_b + (size_t)(l * 2) * D, nullptr, rep_ ? (bf16*)(F.wsb + WS_SH + SH_OP) : F.XB, rep_ > 0, 0x7fffffff, nullptr, 0, DENSE_F8 ? (unsigned char*)F.XG : nullptr);
        PH_END
        if (!moe) {
            PH_BEGIN_G(pb + 6)
                pg8::Gemm g{DENSE_F8 ? F.XG : F.XB, DENSE_F8 ? (bf16*)((unsigned char*)F.WGU_T + (size_t)jj * 2 * FFD * D) : F.WGU_T + (size_t)jj * 2 * FFD * D, T, 2 * FFD, DENSE_F8 ? D / 2 : D}; pg8::StaticOrder S; S.init(T, 2 * FFD, F.G, F.bid, WGM_WIDE);
                pg8::EpiSwigluT<DENSE_DN_F8 != 0> E{F.HID, FFD, DENSE_F8 ? 1.0f / (F8_WS * F8_XS) : 1.0f, F8_HS};
                pg8::gemm_phase<pg8::EpiSwigluT<DENSE_DN_F8 != 0>, pg8::StaticOrder, true, true, DENSE_F8 != 0>(F.lds + RING_OFF, g, S, E);
            PH_END
            PH_BEGIN_G(pb + 7)
                pg8::Gemm g{F.HID, DENSE_DN_F8 ? (bf16*)((unsigned char*)F.WD_T + (size_t)jj * D * FFD) : F.WD_T + (size_t)jj * D * FFD, T, D, DENSE_DN_F8 ? FFD / 2 : FFD}; pg8::StaticOrder S; S.init(T, D, F.G, F.bid, WGM_N1K);
                pg8::EpiBf16<0> E{F.HB, D, nullptr, 0, 0, DENSE_DN_F8 ? 1.0f / (F8_HS * F8_WDS) : 1.f};
                pg8::gemm_phase<pg8::EpiBf16<0>, pg8::StaticOrder, true, true, DENSE_DN_F8 != 0>(F.lds + RING_OFF, g, S, E);
            PH_END
            PH_BEGIN_R(pb + 8, REP_LNX) ph_ln<0, false>(F, nullptr, nullptr, F.ln_g + (size_t)(l * 2 + 1) * D, F.ln_b + (size_t)(l * 2 + 1) * D, nullptr, rep_ ? (bf16*)(F.wsb + WS_SH + SH_OP) : F.XB, rep_ > 0); PH_END
        } else {
            PH_BEGIN_R(pb + 6, REP_GATH) ph_moe_gather(F); PH_END
            PH_BEGIN_R(pb + 7, REP_GEMM * REP_MGU)
                const GAS int* meta = (const GAS int*)(F.TAB + TAB_META);
                pg8::MoeOrder S;
#pragma unroll
                for (int e = 0; e < 8; ++e) S.pend[e] = __builtin_amdgcn_readfirstlane(meta[e]);
                const int nblk = S.pend[7] / 256;
                S.pm_off = 0; S.estride = (size_t)2 * FFE * D * (MOE_GU_F8 ? 1 : 2); S.init(nblk * 256, 2 * FFE, F.G, F.bid, WGM_MGU);
                pg8::Gemm g{F.XG, F.WGUE, nblk * 256, 2 * FFE, MOE_GU_F8 ? D / 2 : D};
                pg8::EpiSwigluT<MOE_DN_F8 != 0> E{F.HIDM, FFE, MOE_GU_F8 ? 1.0f / (F8_WS * F8_XS) : 1.0f, F8_HS};
                pg8::gemm_phase<pg8::EpiSwigluT<MOE_DN_F8 != 0>, pg8::MoeOrder, true, true, MOE_GU_F8 != 0>(F.lds + RING_OFF, g, S, E);
            PH_END
            PH_BEGIN_R(pb + 8, REP_GEMM * REP_MDN)
                const GAS int* meta = (const GAS int*)(F.TAB + TAB_META);
                pg8::MoeOrder S;
#pragma unroll
                for (int e = 0; e < 8; ++e) S.pend[e] = __builtin_amdgcn_readfirstlane(meta[e]);
                const int nblk = S.pend[7] / 256, nlo = nblk & 63, nmain = nblk - nlo;
                S.pm_off = 0; S.estride = (size_t)D * FFE * (MOE_DN_F8 ? 1 : 2); S.init(nmain * 256, D, F.G, F.bid, WGM_N1K);
                pg8::Gemm g{F.HIDM, F.WDE, nmain * 256, D, MOE_DN_F8 ? FFE / 2 : FFE};
                pg8::EpiBf16<0> E{F.XG, D, nullptr, 0, 0, MOE_DN_F8 ? 1.0f / (F8_HS * F8_WDS) : 1.f};
                pg8::gemm_phase<pg8::EpiBf16<0>, pg8::MoeOrder, true, true, MOE_DN_F8 != 0>(F.lds + RING_OFF, g, S, E);
                if (nlo > 0) {
                    pg8::MoeSubOrder S2; S2.nsub = nlo * 4 * 7; S2.G = F.G; S2.c = F.bid; S2.pm_lo = nmain; S2.estride = (size_t)D * FFE * (MOE_DN_F8 ? 1 : 2); S2.kbytes = MOE_DN_F8 ? 512 : 1024;
#pragma unroll
                    for (int e = 0; e < 8; ++e) S2.pend[e] = S.pend[e];
                    pg8::Gemm g2{F.HIDM, F.WDE, nblk * 256, D, MOE_DN_F8 ? 256 : 512, MOE_DN_F8 ? FFE / 2 : FFE};
                    pg8::EpiSlab E2{(bf16*)(F.wsb + WS_SH + SH_SLAB), nmain, (size_t)nlo * 256 * D, MOE_DN_F8 ? 1.0f / (F8_HS * F8_WDS) : 1.f};
                    pg8::gemm_phase<pg8::EpiSlab, pg8::MoeSubOrder, true, true, MOE_DN_F8 != 0>(F.lds + RING_OFF, g2, S2, E2);
                }
            PH_END
            PH_BEGIN_R(pb + 9, REP_LNX)
                const int nblk_ = __builtin_amdgcn_readfirstlane(((const GAS int*)(F.TAB + TAB_META))[7]) / 256, nlo_ = nblk_ & 63;
                ph_ln<2, false>(F, nullptr, (l == DEPTH - 1) ? F.out : nullptr, F.ln_g + (size_t)(l * 2 + 1) * D, F.ln_b + (size_t)(l * 2 + 1) * D, nullptr, rep_ ? (bf16*)(F.wsb + WS_SH + SH_OP) : F.XB, rep_ > 0,
                                (nblk_ - nlo_) * 256, (const bf16*)(F.wsb + WS_SH + SH_SLAB), (size_t)nlo_ * 256 * D);
            PH_END
        }
    }
#undef PH_BEGIN
#undef PH_END
}

#ifndef MK_ONE_LAUNCH
#define MK_ONE_LAUNCH 1
#endif
extern "C" void kernel_launch(void* const* d_in, const int* in_sizes, int n_in, void* d_out, int out_size, void* d_ws, size_t ws_size, hipStream_t stream) {
    static int grid = 0;
    if (grid == 0) {
        if (n_in != 26 || in_sizes[0] != T * D || out_size != T * D || ws_size < WS_END) { fprintf(stderr, "kernel_launch: unexpected shapes (n_in %d, in0 %d, out %d, ws %zu); nothing launched\n", n_in, n_in > 0 ? in_sizes[0] : -1, out_size, ws_size); grid = -1; return; }
        int dev = 0, cus = 0, per_cu = 0;
        if (hipGetDevice(&dev) != hipSuccess || hipDeviceGetAttribute(&cus, hipDeviceAttributeMultiprocessorCount, dev) != hipSuccess) { grid = -1; return; }
        if (hipFuncSetAttribute((const void*)fwd_kernel, hipFuncAttributeMaxDynamicSharedMemorySize, LDS_BYTES) != hipSuccess) { fprintf(stderr, "kernel_launch: hipFuncSetAttribute failed\n"); grid = -1; return; }
        if (hipOccupancyMaxActiveBlocksPerMultiprocessor(&per_cu, (const void*)fwd_kernel, NTHR, LDS_BYTES) != hipSuccess || per_cu < 1) fprintf(stderr, "kernel_launch: occupancy query reports %d\n", per_cu);
        (void)hipGetLastError();
        grid = cus;
    }
    if (grid < 0) return;
    if (hipMemsetAsync((char*)d_ws + WS_CTL, 0, CTL_ZERO_BYTES, stream) != hipSuccess) return;
    Args a{};
    for (int i = 0; i < 26; ++i) a.in[i] = (const float*)d_in[i];
    a.out = (float*)d_out; a.ws = (unsigned char*)d_ws;
#if MK_ONE_LAUNCH
    a.ph_lo = 0; a.ph_hi = N_PHASES;
    hipLaunchKernelGGL(fwd_kernel, dim3(grid), dim3(NTHR), LDS_BYTES, stream, a);
#else
    for (int p = 0; p < N_PHASES; ++p) { a.ph_lo = p; a.ph_hi = p + 1; hipLaunchKernelGGL(fwd_kernel, dim3(grid), dim3(NTHR), LDS_BYTES, stream, a); }
#endif
}
```

```cpp
#include <hip/hip_runtime.h>
#include <cstdio>
#include <cstdint>
namespace pg8 {
#define PG8_LAS __attribute__((address_space(3)))
typedef unsigned short bf16_t;
typedef short bf16x8 __attribute__((ext_vector_type(8)));
typedef float f32x4 __attribute__((ext_vector_type(4)));
typedef unsigned u32x4 __attribute__((ext_vector_type(4)));
constexpr int BM = 256, BK = 64, HALF = 128, HTB = HALF * BK * 2  , STAGE_BYTES = 8 * HTB, NXCD = 8, WGM = 8;

__host__ __device__ __forceinline__ int lds_byte(int r, int c) { const int st = (r >> 4) * 2 + (c >> 5), rr = r & 15, cc = c & 31, ob = rr * 64 + cc * 2; return st * 1024 + (ob ^ (((ob >> 9) & 1) << 5)); }
__host__ __device__ __forceinline__ void stage_rc(int b, int& R, int& C) { const int st = b / 1024, sb = b % 1024, swz = sb ^ (((sb >> 9) & 1) << 5); R = (st >> 1) * 16 + swz / 64; C = (st & 1) * 32 + (swz % 64) / 2; }
__host__ __device__ __forceinline__ int perm32(int rho) { const int n = rho >> 4, i = rho & 15; return 8 * (i >> 2) + 4 * n + (i & 3); }

struct Unit { int pm, pn, kp; };
struct Gemm { const bf16_t* A; const bf16_t* Bt; int M, N, K; int ld = 0; };

struct StaticOrder {
    int nM, nN, nwg, G, c, wgm;
    __host__ __device__ void init(int M, int N, int G_, int c_, int wgm_ = WGM) { nM = M / BM; nN = N / BM; nwg = nM * nN; G = G_; c = c_; wgm = wgm_; }
    __host__ __device__ bool next(int i, Unit& u) const {
        const long L = (long)i * G + c; if (L >= nwg) return false;
        int wgid = (int)L; { const int q = nwg / NXCD, r = nwg % NXCD, xcd = wgid % NXCD, off = wgid / NXCD; wgid = (xcd < r ? xcd * (q + 1) : r * (q + 1) + (xcd - r) * q) + off; }
        const int nig = wgm * nN, gid = wgid / nig, fm = gid * wgm, gsz = (nM - fm) < wgm ? (nM - fm) : wgm;
        u.pm = fm + ((wgid % nig) % gsz); u.pn = (wgid % nig) / gsz; u.kp = 0; return true;
    }
    __device__ __forceinline__ void a_ready(const Unit&) const {}
    __device__ __forceinline__ void done(const Unit&) const {}
    __device__ __forceinline__ size_t b_base_off(const Unit&) const { return 0; }
    __device__ __forceinline__ size_t a_base_off(const Unit&) const { return 0; }
};

__device__ __forceinline__ unsigned cvt_pk_bf16(float lo, float hi) { unsigned r; asm volatile("v_cvt_pk_bf16_f32 %0, %1, %2" : "=v"(r) : "v"(lo), "v"(hi)); return r; }
typedef float f32x2 __attribute__((ext_vector_type(2)));
__device__ __forceinline__ f32x2 gelu_pk(f32x2 v) {
    const f32x2 av = __builtin_elementwise_abs(v), d = av * 0.2316418882f + 1.0f;
    f32x2 t; t.x = __builtin_amdgcn_rcpf(d.x); t.y = __builtin_amdgcn_rcpf(d.y);
    f32x2 q = t * 0.5307027145f + (-0.7265760135f); q = q * t + 0.7107068705f; q = q * t + (-0.142248368f); q = q * t + 0.127414796f; q = q * t;
    const f32x2 s = (v * v) * (-0.72134752044f);
    f32x2 e; e.x = __builtin_amdgcn_exp2f(s.x); e.y = __builtin_amdgcn_exp2f(s.y);
    const f32x2 m = v * (q * e), r = v - m;
    f32x2 o; o.x = v.x < 0.f ? m.x : r.x; o.y = v.y < 0.f ? m.y : r.y; return o;
}

template <int ACT  > struct EpiBf16 {
    static constexpr bool PERM = true, AFTER_DRAIN = false; static_assert(ACT == 0 || ACT == 1, "EpiBf16: ACT is 0 (none) or 1 (gelu_pk)");
    bf16_t* O; int ldc; const float* bias; int split_cols; size_t split_stride; float scale0;
    __device__ __forceinline__ void operator()(const f32x4 (&acc)[2][2][4][2], const Unit& u, int wr, int wc, int fr, int fq) const {
        const int row0 = u.pm * BM + wr * 64 + fr; int colt = u.pn * BM; bf16_t* base = O;
        float sc = 1.f; if (split_cols) { const int t = colt / split_cols; base += (size_t)t * split_stride; colt -= t * split_cols; if (t == 0) sc = scale0; } else sc = scale0;
        const int col0 = colt + wc * 32 + 8 * fq, bcol0 = u.pn * BM + wc * 32 + 8 * fq;
        f32x4 bv[2][2];
#pragma unroll
        for (int bj = 0; bj < 2; ++bj)
#pragma unroll
            for (int n = 0; n < 2; ++n) bv[bj][n] = bias ? *(const f32x4*)(bias + bcol0 + bj * HALF + 4 * n) : (f32x4){0.f, 0.f, 0.f, 0.f};
#pragma unroll
        for (int ai = 0; ai < 2; ++ai)
#pragma unroll
            for (int m = 0; m < 4; ++m) { bf16_t* rowp = base + (size_t)(row0 + ai * HALF + m * 16) * ldc + col0;
#pragma unroll
                for (int bj = 0; bj < 2; ++bj) { f32x4 v0 = acc[ai][bj][m][0] + bv[bj][0], v1 = acc[ai][bj][m][1] + bv[bj][1];
                    if (ACT == 1) { f32x2 a = gelu_pk((f32x2){v0[0], v0[1]}), b = gelu_pk((f32x2){v0[2], v0[3]}), c = gelu_pk((f32x2){v1[0], v1[1]}), d = gelu_pk((f32x2){v1[2], v1[3]});
                        v0 = (f32x4){a.x, a.y, b.x, b.y}; v1 = (f32x4){c.x, c.y, d.x, d.y}; }
                    v0 = v0 * sc; v1 = v1 * sc; u32x4 w; w.x = cvt_pk_bf16(v0[0], v0[1]); w.y = cvt_pk_bf16(v0[2], v0[3]); w.z = cvt_pk_bf16(v1[0], v1[1]); w.w = cvt_pk_bf16(v1[2], v1[3]);
                    *(u32x4*)(rowp + bj * HALF) = w; } }
    }
};

struct PanelStats {
    unsigned* xbuf;
    unsigned* cnt;
    unsigned* tmo;
    int ntn; float eps;
    unsigned code;
    __device__ __forceinline__ bool run(const f32x4 (&v)[2][2][4][2], const Unit& u, int wr, int wc, int fr, int fq, PG8_LAS unsigned char* lds, int wid, int lane) const {
        typedef float f32x2v __attribute__((ext_vector_type(2)));
        PG8_LAS f32x2v* P = (PG8_LAS f32x2v*)lds;
        PG8_LAS f32x2v* S = (PG8_LAS f32x2v*)(lds + 8192);
        PG8_LAS unsigned* flag = (PG8_LAS unsigned*)(lds + 8192 + 2048);
#pragma unroll
        for (int ai = 0; ai < 2; ++ai)
#pragma unroll
            for (int m = 0; m < 4; ++m) {
                float s = 0.f;
#pragma unroll
                for (int bj = 0; bj < 2; ++bj)
#pragma unroll
                    for (int n = 0; n < 2; ++n) { const f32x4 x = v[ai][bj][m][n]; s += (x[0] + x[1]) + (x[2] + x[3]); }
                s += __shfl_xor(s, 16); s += __shfl_xor(s, 32);
                const float mw = s * (1.0f / 64.0f); float q = 0.f;
#pragma unroll
                for (int bj = 0; bj < 2; ++bj)
#pragma unroll
                    for (int n = 0; n < 2; ++n) { const f32x4 d = v[ai][bj][m][n] - mw; q += (d[0] * d[0] + d[1] * d[1]) + (d[2] * d[2] + d[3] * d[3]); }
                q += __shfl_xor(q, 16); q += __shfl_xor(q, 32);
                if (fq == 0) P[(ai * HALF + wr * 64 + m * 16 + fr) * 4 + wc] = (f32x2v){mw, q};
            }
        asm volatile("s_waitcnt lgkmcnt(0)" ::: "memory"); __builtin_amdgcn_s_barrier(); asm volatile("" ::: "memory");
#if defined(BROKEN_EXCHANGE_NO_WAIT)
#warning BROKEN CONTROL BUILD: the row-statistics exchange does not wait; results are wrong by design
        if (blockIdx.x >= 64) { const long long t0_ = clock64(); while (clock64() - t0_ < 60000) __builtin_amdgcn_s_sleep(8); }
#endif
        const int row = wid * 32 + (lane & 31);
        if (lane < 32) {
            const f32x2v a = P[row * 4 + 0], b = P[row * 4 + 1], c = P[row * 4 + 2], d = P[row * 4 + 3];
            const float mt = (a.x + b.x + c.x + d.x) * 0.25f;
            const float da = a.x - mt, db = b.x - mt, dc = c.x - mt, dd = d.x - mt;
            const float m2 = (a.y + b.y) + (c.y + d.y) + 64.0f * ((da * da + db * db) + (dc * dc + dd * dd));
            unsigned long long* slot = (unsigned long long*)xbuf + ((size_t)(u.pm * BM + row) * 4 + u.pn);
            __hip_atomic_store(slot, ((unsigned long long)__float_as_uint(m2) << 32) | __float_as_uint(mt), __ATOMIC_RELAXED, __HIP_MEMORY_SCOPE_AGENT);
        }
        asm volatile("s_waitcnt vmcnt(0)" ::: "memory");
        if (lane == 0) __hip_atomic_fetch_add(cnt + 64 * u.pm, 1u, __ATOMIC_RELAXED, __HIP_MEMORY_SCOPE_AGENT);
        if (wid == 0) {
            bool dead = false; const unsigned long long t0 = __builtin_amdgcn_s_memrealtime(); const unsigned want = 8u * (unsigned)ntn;
            for (;;) {
#if defined(BROKEN_EXCHANGE_NO_WAIT)
                break;
#endif
                if ((unsigned)__builtin_amdgcn_readfirstlane(__hip_atomic_load(cnt + 64 * u.pm, __ATOMIC_RELAXED, __HIP_MEMORY_SCOPE_AGENT)) >= want) break;
                if (__builtin_amdgcn_s_memrealtime() - t0 > 2000000ull) {
                    if (lane == 0) { unsigned expect = 0u; __hip_atomic_compare_exchange_strong(tmo + 1, &expect, code | (unsigned)(u.pm & 0xff), __ATOMIC_RELAXED, __ATOMIC_RELAXED, __HIP_MEMORY_SCOPE_AGENT);
                                     __hip_atomic_store(tmo, 1u, __ATOMIC_RELAXED, __HIP_MEMORY_SCOPE_AGENT); }
                    dead = true; break; }
                __builtin_amdgcn_s_sleep(2);
            }
            __builtin_amdgcn_fence(__ATOMIC_ACQUIRE, "agent");
            if (lane == 0) flag[0] = dead ? 1u : 0u;
        }
        asm volatile("s_waitcnt vmcnt(0) lgkmcnt(0)" ::: "memory"); __builtin_amdgcn_s_barrier(); asm volatile("" ::: "memory");
        const bool bad = flag[0] != 0u;
        if (lane < 32) {
            const unsigned long long* slot = (const unsigned long long*)xbuf + (size_t)(u.pm * BM + row) * 4; float mt[4], m2[4]; float ms = 0.f;
#pragma unroll
            for (int t = 0; t < 4; ++t) { if (t < ntn) { const unsigned long long w = __hip_atomic_load(slot + t, __ATOMIC_RELAXED, __HIP_MEMORY_SCOPE_AGENT); mt[t] = __uint_as_float((unsigned)w); m2[t] = __uint_as_float((unsigned)(w >> 32)); } else { mt[t] = 0.f; m2[t] = 0.f; } ms += mt[t]; }
            const float mean = ms / (float)ntn; float q = 0.f;
#pragma unroll
            for (int t = 0; t < 4; ++t) if (t < ntn) { const float dm = mt[t] - mean; q += m2[t] + 256.0f * dm * dm; }
            S[row] = (f32x2v){mean, 1.0f / sqrtf(q / (256.0f * (float)ntn) + eps)};
        }
        asm volatile("s_waitcnt lgkmcnt(0)" ::: "memory"); __builtin_amdgcn_s_barrier(); asm volatile("" ::: "memory");
        return bad;
    }
};
struct EpiLnRes {
    static constexpr bool PERM = false, AFTER_DRAIN = true;
    const float* base; float* out; int ldc; const float* bias; PanelStats st; unsigned poison;
    __device__ __forceinline__ void fused(f32x4 (&acc)[2][2][4][2], const Unit& u, int wr, int wc, int fr, int fq, PG8_LAS unsigned char* lds, int wid, int lane) const {
        typedef float f32x2v __attribute__((ext_vector_type(2)));
        const PG8_LAS f32x2v* S = (const PG8_LAS f32x2v*)(lds + 8192);
        const int col0 = u.pn * BM + wc * 32 + 4 * fq;
#pragma unroll
        for (int bj = 0; bj < 2; ++bj)
#pragma unroll
            for (int n = 0; n < 2; ++n) { const f32x4 bv = bias ? *(const f32x4*)(bias + col0 + bj * HALF + n * 16) : (f32x4){0.f, 0.f, 0.f, 0.f};
#pragma unroll
                for (int ai = 0; ai < 2; ++ai)
#pragma unroll
                    for (int m = 0; m < 4; ++m) acc[ai][bj][m][n] += bv; }
        f32x4 pre[4][2][2];
#pragma unroll
        for (int m = 0; m < 4; ++m) { const size_t off = (size_t)(u.pm * BM + wr * 64 + m * 16 + fr) * ldc + col0;
#pragma unroll
            for (int bj = 0; bj < 2; ++bj)
#pragma unroll
                for (int n = 0; n < 2; ++n) pre[m][bj][n] = *(const f32x4*)(base + off + bj * HALF + n * 16); }
        const bool bad = st.run(acc, u, wr, wc, fr, fq, lds, wid, lane) || poison != 0u;
        const float qnan = __builtin_nanf("");
#pragma unroll
        for (int ai = 0; ai < 2; ++ai)
#pragma unroll
            for (int m = 0; m < 4; ++m) { const int r = ai * HALF + wr * 64 + m * 16 + fr; const f32x2v sr = S[r]; const size_t off = (size_t)(u.pm * BM + r) * ldc + col0;
#pragma unroll
                for (int bj = 0; bj < 2; ++bj)
#pragma unroll
                    for (int n = 0; n < 2; ++n) { const f32x4 bs = ai == 0 ? pre[m][bj][n] : *(const f32x4*)(base + off + bj * HALF + n * 16); f32x4 o = bs + (acc[ai][bj][m][n] - sr.x) * sr.y;
                        if (bad) o = (f32x4){qnan, qnan, qnan, qnan}; *(f32x4*)(out + off + bj * HALF + n * 16) = o; }
                if (m & 1) asm volatile("" ::: "memory"); }
    }
};
struct EpiLnResLn {
    static constexpr bool PERM = false, AFTER_DRAIN = true;
    const float* base; float* out; bf16_t* xn; int ldc; const float* bias; PanelStats st1, st2; unsigned poison;
    __device__ __forceinline__ void fused(f32x4 (&acc)[2][2][4][2], const Unit& u, int wr, int wc, int fr, int fq, PG8_LAS unsigned char* lds, int wid, int lane) const {
        typedef float f32x2v __attribute__((ext_vector_type(2))); typedef unsigned u32x2v __attribute__((ext_vector_type(2)));
        const PG8_LAS f32x2v* S = (const PG8_LAS f32x2v*)(lds + 8192);
        const int col0 = u.pn * BM + wc * 32 + 4 * fq;
#pragma unroll
        for (int bj = 0; bj < 2; ++bj)
#pragma unroll
            for (int n = 0; n < 2; ++n) { const f32x4 bv = bias ? *(const f32x4*)(bias + col0 + bj * HALF + n * 16) : (f32x4){0.f, 0.f, 0.f, 0.f};
#pragma unroll
                for (int ai = 0; ai < 2; ++ai)
#pragma unroll
                    for (int m = 0; m < 4; ++m) acc[ai][bj][m][n] += bv; }
        bool bad = st1.run(acc, u, wr, wc, fr, fq, lds, wid, lane) || poison != 0u;
        const float qnan = __builtin_nanf("");
#pragma unroll
        for (int ai = 0; ai < 2; ++ai)
#pragma unroll
            for (int m = 0; m < 4; ++m) { const int r = ai * HALF + wr * 64 + m * 16 + fr; const f32x2v sr = S[r]; const size_t off = (size_t)(u.pm * BM + r) * ldc + col0;
#pragma unroll
                for (int bj = 0; bj < 2; ++bj)
#pragma unroll
                    for (int n = 0; n < 2; ++n) { const f32x4 bs = *(const f32x4*)(base + off + bj * HALF + n * 16); acc[ai][bj][m][n] = bs + (acc[ai][bj][m][n] - sr.x) * sr.y; }
                asm volatile("" : "+v"(acc[ai][0][m][0]), "+v"(acc[ai][0][m][1]), "+v"(acc[ai][1][m][0]), "+v"(acc[ai][1][m][1]));
                if (m & 1) asm volatile("" ::: "memory"); }
        const bool bad1 = bad;
        bad = st2.run(acc, u, wr, wc, fr, fq, lds, wid, lane) || bad;
#pragma unroll
        for (int ai = 0; ai < 2; ++ai)
#pragma unroll
            for (int m = 0; m < 4; ++m) { const int r = ai * HALF + wr * 64 + m * 16 + fr; const f32x2v sr = S[r]; const size_t off = (size_t)(u.pm * BM + r) * ldc + col0;
#pragma unroll
                for (int bj = 0; bj < 2; ++bj)
#pragma unroll
                    for (int n = 0; n < 2; ++n) { const f32x4 x1 = acc[ai][bj][m][n]; *(f32x4*)(out + off + bj * HALF + n * 16) = bad1 ? (f32x4){qnan, qnan, qnan, qnan} : x1;
                        const f32x4 o = (x1 - sr.x) * sr.y; u32x2v w; w.x = cvt_pk_bf16(o[0], o[1]); w.y = cvt_pk_bf16(o[2], o[3]);
                        if (bad) { w.x = 0x7fc07fc0u; w.y = 0x7fc07fc0u; } *(u32x2v*)(xn + off + bj * HALF + n * 16) = w; }
                asm volatile("" ::: "memory"); }
    }
};

typedef int i32x4_ __attribute__((ext_vector_type(4)));
typedef int i32x8_ __attribute__((ext_vector_type(8)));
__device__ __forceinline__ i32x8_ cat8(bf16x8 lo, bf16x8 hi) { return __builtin_shufflevector(__builtin_bit_cast(i32x4_, lo), __builtin_bit_cast(i32x4_, hi), 0, 1, 2, 3, 4, 5, 6, 7); }
template <class Epi, class Sched, bool ALIGN_EPI = false, bool SP2 = false, bool F8 = false>
__device__ __forceinline__ void gemm_phase(PG8_LAS unsigned char* lds, const Gemm g, const Sched& S, const Epi& E) {
    int tid_ = threadIdx.x; asm volatile("" : "+v"(tid_));
    const int tid = tid_, wid = __builtin_amdgcn_readfirstlane(tid >> 6), lane = tid & 63, wr = wid >> 2, wc = wid & 3, fr = lane & 15, fq = lane >> 4;
    int K_ = g.K; asm volatile("" : "+s"(K_));
    int LD_ = g.ld ? g.ld : K_; asm volatile("" : "+s"(LD_));
    const int K = K_, nt = K / BK, LD = LD_;
    unsigned voffA[2], voffB[2];
#pragma unroll
    for (int i = 0; i < 2; ++i) { int R, C; stage_rc(tid * 16 + i * 8192, R, C); const int Rb = Epi::PERM ? ((R & ~31) + perm32(R & 31)) : R;
        voffA[i] = (unsigned)(R * LD + C) * 2u; voffB[i] = (unsigned)(Rb * LD + C) * 2u; }
    const size_t kstep = (size_t)(BK * 2);
    const size_t hstep = (size_t)HALF * LD * 2;
    const size_t tstep = 2 * hstep;
    const unsigned ldsw = (unsigned)wid * 1024u;
    const int aoff = lds_byte(wr * 64 + fr, fq * 8), boff = F8 ? aoff + __builtin_amdgcn_readfirstlane(wc * 4096 - wr * 8192) : lds_byte(wc * 32 + fr, fq * 8);
#define PG8_SA(b, h) (((b) * 2 + (h)) * HTB)
#define PG8_SB(b, h) ((4 + (b) * 2 + (h)) * HTB)
#define PG8_STAGE(bufoff, gbase, voff) do { _Pragma("unroll") for (int _i = 0; _i < 2; ++_i) { \
        if constexpr (F8) { unsigned vo_ = (voff)[0]; asm volatile("" : "+v"(vo_));     \
            __builtin_amdgcn_global_load_lds((const unsigned*)((const char*)(gbase) + (size_t)_i * 128 * LD + vo_), (PG8_LAS unsigned*)(lds + (bufoff) + ldsw + _i * 8192), 16, 0, 0); } \
        else __builtin_amdgcn_global_load_lds((const unsigned*)((const char*)(gbase) + (voff)[_i]), (PG8_LAS unsigned*)(lds + (bufoff) + ldsw + _i * 8192), 16, 0, 0); } } while (0)
#define PG8_LDA(dst, b, h) do { _Pragma("unroll") for (int m = 0; m < 4; ++m) _Pragma("unroll") for (int k = 0; k < 2; ++k) dst[m][k] = *(const PG8_LAS bf16x8*)(lds + PG8_SA(b, h) + aoff + m * 2048 + k * 1024); } while (0)
#define PG8_LDB(dst, b, h) do { _Pragma("unroll") for (int n = 0; n < 2; ++n) _Pragma("unroll") for (int k = 0; k < 2; ++k) dst[n][k] = *(const PG8_LAS bf16x8*)(lds + PG8_SB(b, h) + boff + n * 2048 + k * 1024); } while (0)
#define PG8_MMA(ai, bj, At, Bt) do { __builtin_amdgcn_s_setprio(1); \
        if constexpr (F8) { _Pragma("unroll") for (int m = 0; m < 4; ++m) _Pragma("unroll") for (int n = 0; n < 2; ++n) \
            acc[ai][bj][m][n] = __builtin_amdgcn_mfma_scale_f32_16x16x128_f8f6f4(cat8(Bt[n][0], Bt[n][1]), cat8(At[m][0], At[m][1]), acc[ai][bj][m][n], 0, 0, 0, f8one, 0, f8one); } \
        else { _Pragma("unroll") for (int m = 0; m < 4; ++m) _Pragma("unroll") for (int n = 0; n < 2; ++n) _Pragma("unroll") for (int k = 0; k < 2; ++k) \
            acc[ai][bj][m][n] = __builtin_amdgcn_mfma_f32_16x16x32_bf16(Bt[n][k], At[m][k], acc[ai][bj][m][n], 0, 0, 0); } \
        __builtin_amdgcn_s_setprio(0); } while (0)
#define PG8_WAIT_V(n) asm volatile("s_waitcnt vmcnt(" #n ")" ::: "memory")
#define PG8_WAIT_L(n) asm volatile("s_waitcnt lgkmcnt(" #n ")" ::: "memory")
#define PG8_BAR __builtin_amdgcn_s_barrier()
#define PG8_SCHED __builtin_amdgcn_sched_barrier(0)
    int f8one = 0x7f7f7f7f; asm volatile("" : "+s"(f8one));
    Unit cur, nxt; int ui = 0;
    if (!S.next(0, cur)) return;
    f32x4 acc[2][2][4][2];
#pragma unroll
    for (int a = 0; a < 2; ++a)
#pragma unroll
        for (int b = 0; b < 2; ++b)
#pragma unroll
            for (int m = 0; m < 4; ++m)
#pragma unroll
                for (int n = 0; n < 2; ++n) acc[a][b][m][n] = (f32x4){0.f, 0.f, 0.f, 0.f};
    bf16x8 At[4][2], B0[2][2], B1[2][2];
    const char* cA = (const char*)g.A + S.a_base_off(cur) + (size_t)cur.pm * tstep; const char* cB = (const char*)g.Bt + S.b_base_off(cur) + (size_t)cur.pn * tstep;
    S.a_ready(cur);
    if constexpr (SP2) {
        PG8_STAGE(PG8_SB(0, 0), cB, voffB); PG8_STAGE(PG8_SB(0, 1), cB + hstep, voffB); PG8_STAGE(PG8_SA(0, 0), cA, voffA); PG8_STAGE(PG8_SA(0, 1), cA + hstep, voffA);
        if (wr == 1) PG8_BAR;
        PG8_WAIT_V(2); PG8_BAR;
        PG8_STAGE(PG8_SB(1, 0), cB + kstep, voffB); PG8_STAGE(PG8_SA(1, 0), cA + kstep, voffA); PG8_STAGE(PG8_SB(1, 1), cB + hstep + kstep, voffB);
        PG8_WAIT_V(6); PG8_BAR;
    } else {
        PG8_STAGE(PG8_SB(0, 0), cB, voffB); PG8_STAGE(PG8_SA(0, 0), cA, voffA); PG8_STAGE(PG8_SB(0, 1), cB + hstep, voffB); PG8_STAGE(PG8_SA(0, 1), cA + hstep, voffA);
        if (wr == 1) PG8_BAR;
        PG8_WAIT_V(4); PG8_BAR;
        PG8_STAGE(PG8_SB(1, 0), cB + kstep, voffB); PG8_STAGE(PG8_SA(1, 0), cA + kstep, voffA); PG8_STAGE(PG8_SB(1, 1), cB + hstep + kstep, voffB);
        PG8_WAIT_V(6); PG8_BAR;
    }
    for (;;) {
        const bool has_next = S.next(ui + 1, nxt);
        const char* nA = has_next ? (const char*)g.A + S.a_base_off(nxt) + (size_t)nxt.pm * tstep : cA; const char* nB = has_next ? (const char*)g.Bt + S.b_base_off(nxt) + (size_t)nxt.pn * tstep : cB;
        for (int t = 0; t < nt; t += 2) {
            const bool last = (t == nt - 2);
            const char* a1 = cA + (size_t)(t + 1) * kstep;
            const char* a2 = last ? nA : cA + (size_t)(t + 2) * kstep; const char* b2 = last ? nB : cB + (size_t)(t + 2) * kstep;
            const char* a3 = a2 + kstep; const char* b3 = b2 + kstep;
            if (last && has_next) S.a_ready(nxt);
            if constexpr (SP2) {
            PG8_LDB(B0, 0, 0); PG8_LDB(B1, 0, 1); PG8_SCHED; PG8_LDA(At, 0, 0); PG8_STAGE(PG8_SA(1, 1), a1 + hstep, voffA);
            PG8_WAIT_V(8); PG8_WAIT_L(0); PG8_BAR; PG8_MMA(0, 0, At, B0); PG8_MMA(0, 1, At, B1); PG8_BAR; PG8_SCHED;
            PG8_LDA(At, 0, 1); PG8_STAGE(PG8_SB(0, 0), b2, voffB); PG8_STAGE(PG8_SB(0, 1), b2 + hstep, voffB); PG8_STAGE(PG8_SA(0, 0), a2, voffA);
            PG8_WAIT_V(8); PG8_WAIT_L(0); PG8_BAR; PG8_MMA(1, 0, At, B0); PG8_MMA(1, 1, At, B1); PG8_BAR; PG8_SCHED;
            PG8_LDB(B0, 1, 0); PG8_LDB(B1, 1, 1); PG8_SCHED; PG8_LDA(At, 1, 0); PG8_STAGE(PG8_SA(0, 1), a2 + hstep, voffA);
            PG8_WAIT_V(8); PG8_WAIT_L(0); PG8_BAR; PG8_MMA(0, 0, At, B0); PG8_MMA(0, 1, At, B1); PG8_BAR; PG8_SCHED;
            PG8_LDA(At, 1, 1); PG8_STAGE(PG8_SB(1, 0), b3, voffB); PG8_STAGE(PG8_SB(1, 1), b3 + hstep, voffB); PG8_STAGE(PG8_SA(1, 0), a3, voffA);
            PG8_WAIT_V(8); PG8_WAIT_L(0); PG8_BAR; PG8_MMA(1, 0, At, B0); PG8_MMA(1, 1, At, B1); PG8_BAR; PG8_SCHED;
            } else {
            PG8_LDB(B0, 0, 0); PG8_SCHED; PG8_LDA(At, 0, 0); PG8_STAGE(PG8_SA(1, 1), a1 + hstep, voffA);
            PG8_WAIT_L(8); PG8_BAR; PG8_WAIT_L(0); PG8_MMA(0, 0, At, B0); PG8_BAR; PG8_SCHED;
            PG8_LDB(B1, 0, 1); PG8_STAGE(PG8_SB(0, 0), b2, voffB);
            PG8_BAR; PG8_WAIT_L(0); PG8_MMA(0, 1, At, B1); PG8_BAR;
            PG8_LDA(At, 0, 1); PG8_STAGE(PG8_SA(0, 0), a2, voffA);
            PG8_BAR; PG8_WAIT_L(0); PG8_MMA(1, 0, At, B0); PG8_BAR; PG8_SCHED;
            PG8_STAGE(PG8_SB(0, 1), b2 + hstep, voffB);
            PG8_WAIT_V(6); PG8_BAR; PG8_MMA(1, 1, At, B1); PG8_BAR;
            PG8_LDB(B0, 1, 0); PG8_SCHED; PG8_LDA(At, 1, 0); PG8_STAGE(PG8_SA(0, 1), a2 + hstep, voffA);
            PG8_WAIT_L(8); PG8_BAR; PG8_WAIT_L(0); PG8_MMA(0, 0, At, B0); PG8_BAR; PG8_SCHED;
            PG8_LDB(B1, 1, 1); PG8_STAGE(PG8_SB(1, 0), b3, voffB);
            PG8_BAR; PG8_WAIT_L(0); PG8_MMA(0, 1, At, B1); PG8_BAR;
            PG8_LDA(At, 1, 1); PG8_STAGE(PG8_SA(1, 0), a3, voffA);
            PG8_BAR; PG8_WAIT_L(0); PG8_MMA(1, 0, At, B0); PG8_BAR; PG8_SCHED;
            PG8_STAGE(PG8_SB(1, 1), b3 + hstep, voffB);
            PG8_WAIT_V(6); PG8_BAR; PG8_MMA(1, 1, At, B1); PG8_BAR;
            }
        }
        if constexpr (ALIGN_EPI) { if (wr == 0) PG8_BAR; }
        int fr_e = fr, fq_e = fq; if constexpr (F8) { int t2_ = threadIdx.x; asm volatile("" : "+v"(t2_)); fr_e = t2_ & 15; fq_e = (t2_ & 63) >> 4; }
        if constexpr (!Epi::AFTER_DRAIN) { E(acc, cur, wr, wc, fr_e, fq_e); S.done(cur); }
        if (!has_next) break;
#pragma unroll
        for (int a = 0; a < 2; ++a)
#pragma unroll
            for (int b = 0; b < 2; ++b)
#pragma unroll
                for (int m = 0; m < 4; ++m)
#pragma unroll
                    for (int n = 0; n < 2; ++n) acc[a][b][m][n] = (f32x4){0.f, 0.f, 0.f, 0.f};
        cur = nxt; cA = nA; cB = nB; ++ui;
        if constexpr (ALIGN_EPI) { if (wr == 1) PG8_BAR; }
    }
    PG8_WAIT_V(0);
    if constexpr (!ALIGN_EPI) { if (wr == 0) PG8_BAR; }
    PG8_BAR;
    if constexpr (Epi::AFTER_DRAIN) { E.fused(acc, cur, wr, wc, fr, fq, lds, wid, lane); S.done(cur); }
#undef PG8_SA
#undef PG8_SB
#undef PG8_STAGE
#undef PG8_LDA
#undef PG8_LDB
#undef PG8_MMA
#undef PG8_WAIT_V
#undef PG8_WAIT_L
#undef PG8_BAR
#undef PG8_SCHED
}
}

namespace pg8 {
struct EpiF32 {
    static constexpr bool PERM = false, AFTER_DRAIN = false;
    float* O; int ldc;
    __device__ __forceinline__ void operator()(const f32x4 (&acc)[2][2][4][2], const Unit& u, int wr, int wc, int fr, int fq) const {
        const int row0 = u.pm * BM + wr * 64 + fr, col0 = u.pn * BM + wc * 32 + 4 * fq;
#pragma unroll
        for (int ai = 0; ai < 2; ++ai)
#pragma unroll
            for (int m = 0; m < 4; ++m) { float* rowp = O + (size_t)(row0 + ai * HALF + m * 16) * ldc + col0;
#pragma unroll
                for (int bj = 0; bj < 2; ++bj)
#pragma unroll
                    for (int n = 0; n < 2; ++n) *(f32x4*)(rowp + bj * HALF + n * 16) = acc[ai][bj][m][n]; }
    }
};
__device__ __forceinline__ float silu_mul(float g, float u) { return g * __builtin_amdgcn_rcpf(1.0f + __expf(-g)) * u; }
template <bool O8> struct EpiSwigluT {
    static constexpr bool PERM = true, AFTER_DRAIN = false;
    bf16_t* O; int ldc; float sc; float osc = 1.f;
    __device__ __forceinline__ void operator()(const f32x4 (&acc)[2][2][4][2], const Unit& u, int wr, int wc, int fr, int fq) const {
        const int row0 = u.pm * BM + wr * 64 + fr, col0 = u.pn * HALF + wc * 32 + 8 * fq;
#pragma unroll
        for (int ai = 0; ai < 2; ++ai)
#pragma unroll
            for (int m = 0; m < 4; ++m) { bf16_t* rowp = O + (size_t)(row0 + ai * HALF + m * 16) * ldc + col0;
                const float c1 = -1.4426950408889634f * sc, kk = sc * sc * (O8 ? osc : 1.f);
                f32x2 r[4];
#pragma unroll
                for (int hf = 0; hf < 4; ++hf) { const f32x4 gq = acc[ai][0][m][hf >> 1], uq = acc[ai][1][m][hf >> 1];
                    const f32x2 ga = (hf & 1) ? (f32x2){gq[2], gq[3]} : (f32x2){gq[0], gq[1]}, ua = (hf & 1) ? (f32x2){uq[2], uq[3]} : (f32x2){uq[0], uq[1]};
                    const f32x2 t = ga * c1; f32x2 e; e.x = __builtin_amdgcn_exp2f(t.x); e.y = __builtin_amdgcn_exp2f(t.y);
                    const f32x2 d = e + 1.0f; f32x2 q; q.x = __builtin_amdgcn_rcpf(d.x); q.y = __builtin_amdgcn_rcpf(d.y);
                    r[hf] = ((ga * kk) * ua) * q; }
                if constexpr (O8) { unsigned char* rp8 = (unsigned char*)O + (size_t)(row0 + ai * HALF + m * 16) * ldc + col0; int w0 = 0, w1 = 0;
                    w0 = __builtin_amdgcn_cvt_pk_fp8_f32(r[0].x, r[0].y, w0, false); w0 = __builtin_amdgcn_cvt_pk_fp8_f32(r[1].x, r[1].y, w0, true);
                    w1 = __builtin_amdgcn_cvt_pk_fp8_f32(r[2].x, r[2].y, w1, false); w1 = __builtin_amdgcn_cvt_pk_fp8_f32(r[3].x, r[3].y, w1, true);
                    typedef unsigned u32x2_ __attribute__((ext_vector_type(2))); *(u32x2_*)rp8 = (u32x2_){(unsigned)w0, (unsigned)w1}; continue; }
                u32x4 w;
                w.x = cvt_pk_bf16(r[0].x, r[0].y); w.y = cvt_pk_bf16(r[1].x, r[1].y); w.z = cvt_pk_bf16(r[2].x, r[2].y); w.w = cvt_pk_bf16(r[3].x, r[3].y);
                *(u32x4*)rowp = w; }
    }
};
typedef EpiSwigluT<false> EpiSwiglu;
struct EpiPlane {
    static constexpr bool PERM = true, AFTER_DRAIN = false;
    bf16_t* O;
    __device__ __forceinline__ void operator()(const f32x4 (&acc)[2][2][4][2], const Unit& u, int wr, int wc, int fr, int fq) const {
        const int row0 = u.pm * BM + wr * 64 + fr, col0 = u.pn * BM + wc * 32 + 8 * fq;
#pragma unroll
        for (int ai = 0; ai < 2; ++ai)
#pragma unroll
            for (int m = 0; m < 4; ++m) { const int row = row0 + ai * HALF + m * 16;
#pragma unroll
                for (int bj = 0; bj < 2; ++bj) { const int col = col0 + bj * HALF;
                    bf16_t* dst = O + ((((size_t)(row >> 12) * 56 + (col >> 6)) * 4096 + (row & 4095)) * 64 + (col & 63));
                    const f32x4 v0 = acc[ai][bj][m][0], v1 = acc[ai][bj][m][1]; u32x4 w; w.x = cvt_pk_bf16(v0[0], v0[1]); w.y = cvt_pk_bf16(v0[2], v0[3]); w.z = cvt_pk_bf16(v1[0], v1[1]); w.w = cvt_pk_bf16(v1[2], v1[3]);
                    *(u32x4*)dst = w; } }
    }
};
struct MoeOrder : StaticOrder {
    int pm_off; int pend[8]; size_t estride;
    __device__ __forceinline__ size_t b_base_off(const Unit& u) const {
        const int rb = (u.pm + pm_off) * BM; int e = 0;
#pragma unroll
        for (int k = 0; k < 7; ++k) e += (rb >= pend[k]) ? 1 : 0;
        return (size_t)__builtin_amdgcn_readfirstlane(e) * estride;
    }
};
struct MoeSubOrder {
    int nsub, G, c, pm_lo; int pend[8]; size_t estride;
    __device__ __forceinline__ bool next(int i, Unit& u) const { const long s = (long)i * G + c; if (s >= nsub) return false; const int tile = (int)s / 7; u.kp = (int)s % 7; u.pm = pm_lo + (tile >> 2); u.pn = tile & 3; return true; }
    __device__ __forceinline__ void a_ready(const Unit&) const {}
    __device__ __forceinline__ void done(const Unit&) const {}
    int kbytes = 1024;
    __device__ __forceinline__ size_t a_base_off(const Unit& u) const { return (size_t)u.kp * kbytes; }
    __device__ __forceinline__ size_t b_base_off(const Unit& u) const {
        const int rb = u.pm * BM; int e = 0;
#pragma unroll
        for (int k = 0; k < 7; ++k) e += (rb >= pend[k]) ? 1 : 0;
        return (size_t)__builtin_amdgcn_readfirstlane(e) * estride + (size_t)u.kp * kbytes;
    }
};
struct EpiSlab {
    static constexpr bool PERM = true, AFTER_DRAIN = false;
    bf16_t* O; int pm_lo; size_t slab_stride; float sc = 1.f;
    __device__ __forceinline__ void operator()(const f32x4 (&acc)[2][2][4][2], const Unit& u, int wr, int wc, int fr, int fq) const {
        const int row0 = (u.pm - pm_lo) * BM + wr * 64 + fr, col0 = u.pn * BM + wc * 32 + 8 * fq; bf16_t* base = O + (size_t)u.kp * slab_stride;
#pragma unroll
        for (int ai = 0; ai < 2; ++ai)
#pragma unroll
            for (int m = 0; m < 4; ++m) { bf16_t* rowp = base + (size_t)(row0 + ai * HALF + m * 16) * 1024 + col0;
#pragma unroll
                for (int bj = 0; bj < 2; ++bj) { const f32x4 v0 = acc[ai][bj][m][0] * sc, v1 = acc[ai][bj][m][1] * sc; u32x4 w; w.x = cvt_pk_bf16(v0[0], v0[1]); w.y = cvt_pk_bf16(v0[2], v0[3]); w.z = cvt_pk_bf16(v1[0], v1[1]); w.w = cvt_pk_bf16(v1[2], v1[3]);
                    *(u32x4*)(rowp + bj * HALF) = w; } }
    }
};
}

#ifndef DENSE_F8
#define DENSE_F8 0
#endif
#ifndef DENSE_DN_F8
#define DENSE_DN_F8 1
#endif
#ifndef MOE_DN_F8
#define MOE_DN_F8 1
#endif
#ifndef MOE_GU_F8
#define MOE_GU_F8 1
#endif
constexpr int NWAVES = 8, NTHR = 512;
constexpr int NB = 8, SEQ = 4096, D = 1024, T = NB * SEQ, DEPTH = 4;
constexpr int NIN = 3584;
constexpr int C_AQ = 1024, C_AK = 1536, C_AV = 2048, C_RQ = 2560, C_RK = 2816, C_RV = 3072, C_RG = 3328;
constexpr int FFD = 2816, FFE = 3584, NE = 8;
constexpr int MOE_ROWS = 2 * T + NE * 256;
constexpr int HID_HALF_BLKS = 132;
constexpr float LN_EPS = 1e-5f, ALPHA = 1.681792830507429f;

constexpr size_t MiB = 1u << 20;
constexpr size_t WS_CTL = 0, CTL_ZERO_BYTES = 1 * MiB;
constexpr size_t WS_TAB = 1 * MiB;
constexpr size_t WS_WIN = 4 * MiB, WS_WOUT = 32 * MiB, WS_WGU = 40 * MiB, WS_WD = 62 * MiB, WS_WGUE = 73 * MiB, WS_WDE = 185 * MiB;
constexpr size_t WS_XB = 241 * MiB, WS_SH = 305 * MiB, WS_END = (305 + 627) * MiB;
constexpr size_t SH_P = 0, SH_Y = 224 * MiB, SH_OP = 288 * MiB, SH_LSE = 384 * MiB, SH_RWS = 387 * MiB, SH_RTS = 531 * MiB;
constexpr size_t SH_H = 0, SH_HID = 64 * MiB, SH_HIDM = 0, SH_XG = 462 * MiB, SH_TOK = 594 * MiB, SH_SLAB = 596 * MiB;
static_assert((size_t)MOE_ROWS * FFE * 2 <= 462 * MiB && (size_t)T * FFD * 2 <= 462 * MiB && (size_t)MOE_ROWS * D * 2 <= 132 * MiB, "ffn buffers");
constexpr int CW_BAR = 4096;
constexpr size_t TABB_WUPT = 1310720, TABB_AUPT = TABB_WUPT + 131072, TABB_GUPT = TABB_AUPT + 131072;
constexpr int TAB_BIAS = 0, TAB_COS = 4096, TAB_SIN = 4096 + 4096 * 32, TAB_META = 4096 + 2 * 4096 * 32;
constexpr size_t TOK_TI = 0, TOK_TG = (size_t)T * 16, TOK_TP = TOK_TG + (size_t)T * 8, TOK_CW = TOK_TP + (size_t)T * 8;

constexpr int RING_OFF = 0, RING_BYTES = 131072, LDSCTL_OFF = RING_BYTES, MISC_OFF = LDSCTL_OFF + 320, LDS_BYTES = 147456;

#define GAS __attribute__((address_space(1)))
#define LAS __attribute__((address_space(3)))
typedef unsigned short bf16;
typedef unsigned v4u __attribute__((ext_vector_type(4)));
typedef unsigned v2u __attribute__((ext_vector_type(2)));
typedef int v4i __attribute__((ext_vector_type(4)));
typedef int v2i __attribute__((ext_vector_type(2)));
typedef float f32x4 __attribute__((ext_vector_type(4)));
typedef float f32x2 __attribute__((ext_vector_type(2)));
typedef GAS unsigned gu32;
#define RLX_AGENT __ATOMIC_RELAXED, __HIP_MEMORY_SCOPE_AGENT
#define LDS_WAIT() asm volatile("s_waitcnt lgkmcnt(0)" ::: "memory")
#define VM_WAIT() asm volatile("s_waitcnt vmcnt(0)" ::: "memory")
typedef float f32x2_t_ __attribute__((ext_vector_type(2))); typedef __bf16 bf16x2_t_ __attribute__((ext_vector_type(2)));
__device__ __forceinline__ unsigned pk2(float lo, float hi) { const f32x2_t_ v = {lo, hi}; return __builtin_bit_cast(unsigned, __builtin_convertvector(v, bf16x2_t_)); }
__device__ __forceinline__ unsigned pk2h(float lo, float hi) { return pk2(lo, hi); }
__device__ __forceinline__ unsigned pk4f8(float a, float b, float c, float d, float s) { int w = 0; w = __builtin_amdgcn_cvt_pk_fp8_f32(a * s, b * s, w, false); w = __builtin_amdgcn_cvt_pk_fp8_f32(c * s, d * s, w, true); return (unsigned)w; }
__device__ __forceinline__ unsigned f2bf(float f) { return pk2(f, 0.f) & 0xffffu; }
__device__ __forceinline__ float bflo(unsigned u) { return __builtin_bit_cast(float, u << 16); }
__device__ __forceinline__ float bfhi(unsigned u) { return __builtin_bit_cast(float, u & 0xffff0000u); }
__device__ __forceinline__ float bf2f(bf16 v) { return __builtin_bit_cast(float, (unsigned)v << 16); }
__device__ __forceinline__ size_t pix(size_t tok, int col) { return (((tok >> 12) * 56 + (size_t)(col >> 6)) * 4096 + (tok & 4095)) * 64 + (size_t)(col & 63); }
constexpr size_t PLANE = 4096 * 64;
#define PIN(x) asm volatile("" : "+v"(x))
__device__ __forceinline__ f32x4 zero4() { int zi = 0; asm volatile("" : "+s"(zi)); const float z = __builtin_bit_cast(float, zi); return (f32x4){z, z, z, z}; }
__device__ __forceinline__ float sigm(float x) { return __builtin_amdgcn_rcpf(1.0f + __expf(-x)); }
__device__ __forceinline__ float rdl(float v, int l) { return __builtin_bit_cast(float, __builtin_amdgcn_readlane(__builtin_bit_cast(int, v), l)); }
template <int CTRL, int RM, int BM, bool BC> __device__ __forceinline__ float dpp_f(float old, float v) {
    return __builtin_bit_cast(float, __builtin_amdgcn_update_dpp(__builtin_bit_cast(int, old), __builtin_bit_cast(int, v), CTRL, RM, BM, BC)); }
__device__ __forceinline__ float wave_sum(float v) {
    v += dpp_f<0x111, 0xf, 0xf, true>(0.f, v); v += dpp_f<0x112, 0xf, 0xf, true>(0.f, v); v += dpp_f<0x114, 0xf, 0xf, true>(0.f, v); v += dpp_f<0x118, 0xf, 0xf, true>(0.f, v);
    v += dpp_f<0x142, 0xa, 0xf, false>(0.f, v); v += dpp_f<0x143, 0xc, 0xf, false>(0.f, v);
    return __builtin_bit_cast(float, __builtin_amdgcn_readlane(__builtin_bit_cast(int, v), 63)); }
__device__ __forceinline__ float sum16(float v) {
    v += dpp_f<0xB1, 0xf, 0xf, true>(0.f, v); v += dpp_f<0x4E, 0xf, 0xf, true>(0.f, v); v += dpp_f<0x141, 0xf, 0xf, true>(0.f, v); v += dpp_f<0x140, 0xf, 0xf, true>(0.f, v); return v; }
__device__ __forceinline__ void swap16(float& a, float& b) { asm volatile("s_nop 1\n\tv_permlane16_swap_b32 %0, %1\n\ts_nop 1" : "+v"(a), "+v"(b)); }
__device__ __forceinline__ void swap32(float& a, float& b) { asm volatile("s_nop 1\n\tv_permlane32_swap_b32 %0, %1\n\ts_nop 1" : "+v"(a), "+v"(b)); }
__device__ __forceinline__ float max_x4(float x) { float a = x, b = x; swap16(a, b); x = fmaxf(a, b); a = x; b = x; swap32(a, b); return fmaxf(a, b); }
__device__ __forceinline__ float sum_x4(float x) { float a = x, b = x; swap16(a, b); x = a + b; a = x; b = x; swap32(a, b); return a + b; }
__device__ __forceinline__ float xor32(float x, int lane) { float a = x, b = x; swap32(a, b); return lane < 32 ? b : a; }

#define XB_TMO      128
#define XB_XCNT(j)  (256  + 64 * (j))
#define XB_XSUB(j)  (1280 + 64 * (j))
#define XB_XGEN(j)  (2304 + 64 * (j))
#define XB_TOP      3328
#define XB_TOPGEN   3392
#define XCD_BAR_WORDS 3456
#define XB_SPIN_CAP (1u << 18)

__device__ __forceinline__ unsigned xb_ld(unsigned* p)              { return __hip_atomic_load(p, __ATOMIC_RELAXED, __HIP_MEMORY_SCOPE_AGENT); }
__device__ __forceinline__ unsigned xb_add(unsigned* p, unsigned v) { return __hip_atomic_fetch_add(p, v, __ATOMIC_RELAXED, __HIP_MEMORY_SCOPE_AGENT); }
__device__ __forceinline__ unsigned xb_xcc_id() { return (unsigned)__builtin_amdgcn_s_getreg((3 << 11) | 20) & 0xFu; }
#define XB_SPIN(cond, bar) do { unsigned _sp = 0; while (cond) { __builtin_amdgcn_s_sleep(1); \
    if ((++_sp & 255u) == 0u) { if (xb_ld(&(bar)[XB_TMO])) break; if (_sp > XB_SPIN_CAP) { atomicAdd(&(bar)[XB_TMO], 1u); break; } } } } while (0)

struct XcdBarrier {
    unsigned* bar; unsigned x;
    volatile LAS unsigned* st;
};

__device__ __forceinline__ XcdBarrier xcd_barrier_post(unsigned* bar, volatile LAS unsigned* st) {
    XcdBarrier b; b.bar = bar; b.x = xb_xcc_id(); b.st = st;
    if (threadIdx.x == 0) (void)xb_add(&bar[XB_XCNT(b.x)], 1u);
    return b;
}
__device__ __forceinline__ void xcd_barrier_complete(unsigned* bar, unsigned x, unsigned& nloc, unsigned& nx) {
    const unsigned G = gridDim.x * gridDim.y * gridDim.z;
    unsigned sum, cnt, mine, sp = 0u;
    for (;;) {
        sum = 0u; cnt = 0u; mine = 0u;
#pragma unroll
        for (unsigned j = 0; j < 16; ++j) { const unsigned c = xb_ld(&bar[XB_XCNT(j)]); sum += c; cnt += (c > 0u) ? 1u : 0u; mine = (j == x) ? c : mine; }
        if (sum == G) break;
        __builtin_amdgcn_s_sleep(1);
        if ((++sp & 255u) == 0u) { if (xb_ld(&bar[XB_TMO])) break; if (sp > XB_SPIN_CAP) { atomicAdd(&bar[XB_TMO], 1u); break; } }
    }
    nloc = mine > 0u ? mine : 1u; nx = cnt > 0u ? cnt : 1u;
}

__device__ __forceinline__ void xcd_barrier(const XcdBarrier& b) {
    asm volatile("s_waitcnt vmcnt(0)" ::: "memory");
    __syncthreads();
    if (threadIdx.x == 0) {
        unsigned* bar = b.bar;
        __builtin_amdgcn_s_waitcnt(0);
        unsigned nloc = b.st[0], nx = b.st[1];
        if (nloc == 0u) { xcd_barrier_complete(bar, b.x, nloc, nx); b.st[0] = nloc; b.st[1] = nx; }
        const unsigned old = xb_add(&bar[XB_XSUB(b.x)], 1u);
        const unsigned gen = old / nloc;
        if (old + 1u == (gen + 1u) * nloc) {
            __builtin_amdgcn_fence(__ATOMIC_RELEASE, "agent");
            asm volatile("s_waitcnt vmcnt(0)" ::: "memory");
            const unsigned og = xb_add(&bar[XB_TOP], 1u);
            const unsigned tg = og / nx;
            if (og + 1u == (tg + 1u) * nx) xb_add(&bar[XB_TOPGEN], 1u);
            else XB_SPIN(xb_ld(&bar[XB_TOPGEN]) == tg, bar);
            __builtin_amdgcn_fence(__ATOMIC_ACQUIRE, "agent");
            xb_add(&bar[XB_XGEN(b.x)], 1u);
            asm volatile("s_waitcnt vmcnt(0)" ::: "memory");
        } else {
            XB_SPIN(xb_ld(&bar[XB_XGEN(b.x)]) == gen, bar);
            __builtin_amdgcn_fence(__ATOMIC_ACQUIRE, "agent");
            asm volatile("s_waitcnt vmcnt(0)" ::: "memory");
        }
    }
    __syncthreads();
}


struct Frame {
    LAS unsigned char* lds;
    volatile LAS unsigned* MISC;
    gu32* ctl;
    int tid, lane, wave, G, bid, lo, hi;
    const float *x, *w_in, *w_out, *mu, *w0, *w_up, *a0, *a_up, *g_up, *k_k, *k_a, *r_k, *rln_g, *rln_b, *gn_g, *gn_b, *rel_bias, *ln_g, *ln_b;
    const float *ffn_g, *ffn_u, *ffn_d, *router, *moe_g, *moe_u, *moe_d;
    float* out;
    float* TAB;
    bf16 *WIN_T, *WOUT_T, *WGU_T, *WD_T, *WGUE, *WDE, *XB, *P, *Y, *HID, *HIDM, *XG;
    bf16 *HB;
    unsigned char* TOK; unsigned char* wsb;
};

constexpr float F8_WS = 256.f, F8_XS = 8.f, F8_HS = 8.f, F8_WDS = 1024.f;
__device__ __forceinline__ void transpose_item(const float* W, int K, int N, bf16* WT, LAS float* scr, int item, int lane, int mode, bool f8 = false, float f8s = F8_WS) {
    const int nblk = N / 32, kb = item / nblk, nb = item % nblk, k0 = 64 * kb, n0 = 32 * nb;
#pragma unroll 8
    for (int i = 0; i < 32; ++i) { const int kk = 2 * i + (lane >> 5); scr[kk * 33 + (lane & 31)] = W[(size_t)(k0 + kk) * N + n0 + (lane & 31)]; }
    LDS_WAIT(); asm volatile("" ::: "memory");
    const int drow0 = (mode == 0) ? n0 : ((n0 >> 7) * 256 + (n0 & 127) + (mode == 2 ? 128 : 0));
    const int c = lane & 7;
#pragma unroll
    for (int j = 0; j < 4; ++j) { const int n = (lane >> 3) + 8 * j; const LAS float* s = scr + (8 * c) * 33 + n;
        if (f8) { v2u o; o.x = pk4f8(s[0 * 33], s[1 * 33], s[2 * 33], s[3 * 33], f8s); o.y = pk4f8(s[4 * 33], s[5 * 33], s[6 * 33], s[7 * 33], f8s);
            *(GAS v2u*)((unsigned char*)WT + (size_t)(drow0 + n) * K + k0 + 8 * c) = o; }
        else { v4u o; o.x = pk2(s[0 * 33], s[1 * 33]); o.y = pk2(s[2 * 33], s[3 * 33]); o.z = pk2(s[4 * 33], s[5 * 33]); o.w = pk2(s[6 * 33], s[7 * 33]);
            *(GAS v4u*)(WT + (size_t)(drow0 + n) * K + k0 + 8 * c) = o; } }
    LDS_WAIT(); asm volatile("" ::: "memory");
}
__device__ __forceinline__ void convert_moe(Frame& F, int j) {
    LAS float* scr = (LAS float*)(F.lds + F.wave * 16384);
    const int gw = F.bid * NWAVES + F.wave, NGW = F.G * NWAVES;
    constexpr int I_E = 1792, PER_E = 3 * I_E, NIT = NE * PER_E;
    for (int it = gw; it < NIT; it += NGW) {
        const int e = it / PER_E; int r = it - e * PER_E;
        const size_t eo = (size_t)(j * NE + e) * D * FFE;
        if (r < I_E) transpose_item(F.moe_g + eo, D, FFE, MOE_GU_F8 ? (bf16*)((unsigned char*)F.WGUE + (size_t)e * 2 * FFE * D) : F.WGUE + (size_t)e * 2 * FFE * D, scr, r, F.lane, 1, MOE_GU_F8);
        else if (r < 2 * I_E) transpose_item(F.moe_u + eo, D, FFE, MOE_GU_F8 ? (bf16*)((unsigned char*)F.WGUE + (size_t)e * 2 * FFE * D) : F.WGUE + (size_t)e * 2 * FFE * D, scr, r - I_E, F.lane, 2, MOE_GU_F8);
        else transpose_item(F.moe_d + eo, FFE, D, MOE_DN_F8 ? (bf16*)((unsigned char*)F.WDE + (size_t)e * D * FFE) : F.WDE + (size_t)e * D * FFE, scr, r - 2 * I_E, F.lane, 0, MOE_DN_F8, F8_WDS);
    }
}
__device__ __forceinline__ void sincos_pos(double x, float& s, float& c) {
    const double kd = __builtin_rint(x * 0.63661977236758134308);
    const double r = (x - kd * 1.57079632679489655800e+00) - kd * 6.12323399573676603587e-17;
    const int k = (int)kd & 3; const double r2 = r * r;
    const double sp = r * (1.0 + r2 * (-1.0 / 6 + r2 * (1.0 / 120 + r2 * (-1.0 / 5040 + r2 * (1.0 / 362880 + r2 * (-1.0 / 39916800 + r2 * (1.0 / 6227020800.0)))))));
    const double cp = 1.0 + r2 * (-0.5 + r2 * (1.0 / 24 + r2 * (-1.0 / 720 + r2 * (1.0 / 40320 + r2 * (-1.0 / 3628800 + r2 * (1.0 / 479001600 + r2 * (-1.0 / 87178291200.0)))))));
    const double ss = (k == 0) ? sp : (k == 1) ? cp : (k == 2) ? -sp : -cp;
    const double cc = (k == 0) ? cp : (k == 1) ? -sp : (k == 2) ? -cp : sp;
    s = (float)ss; c = (float)cc;
}
__device__ __forceinline__ void ph_prologue(Frame& F) {
    LAS float* scr = (LAS float*)(F.lds + F.wave * 16384);
    const int gw = F.bid * NWAVES + F.wave, NGW = F.G * NWAVES;
    constexpr int I_IN = 16 * 112, I_OUT = 16 * 32, I_GU = 16 * 88, I_DN = 44 * 32;
    constexpr int PER_L = I_IN + I_OUT, PER_J = 2 * I_GU + I_DN, N1 = 4 * PER_L + 2 * PER_J;
    for (int it = gw; it < N1; it += NGW) {
        int r = it;
        if (r < 4 * PER_L) { const int l = r / PER_L; r -= l * PER_L;
            if (r < I_IN) transpose_item(F.w_in + (size_t)l * D * NIN, D, NIN, F.WIN_T + (size_t)l * NIN * D, scr, r, F.lane, 0);
            else transpose_item(F.w_out + (size_t)l * D * D, D, D, F.WOUT_T + (size_t)l * D * D, scr, r - I_IN, F.lane, 0);
        } else { r -= 4 * PER_L; const int j = r / PER_J; r -= j * PER_J;
            if (r < I_GU) transpose_item(F.ffn_g + (size_t)j * D * FFD, D, FFD, DENSE_F8 ? (bf16*)((unsigned char*)F.WGU_T + (size_t)j * 2 * FFD * D) : F.WGU_T + (size_t)j * 2 * FFD * D, scr, r, F.lane, 1, DENSE_F8, F8_WS);
            else if (r < 2 * I_GU) transpose_item(F.ffn_u + (size_t)j * D * FFD, D, FFD, DENSE_F8 ? (bf16*)((unsigned char*)F.WGU_T + (size_t)j * 2 * FFD * D) : F.WGU_T + (size_t)j * 2 * FFD * D, scr, r - I_GU, F.lane, 2, DENSE_F8, F8_WS);
            else transpose_item(F.ffn_d + (size_t)j * FFD * D, FFD, D, DENSE_DN_F8 ? (bf16*)((unsigned char*)F.WD_T + (size_t)j * D * FFD) : F.WD_T + (size_t)j * D * FFD, scr, r - 2 * I_GU, F.lane, 0, DENSE_DN_F8, F8_WDS);
        }
    }
    convert_moe(F, 0);
    { const size_t n8 = (size_t)T * D / 8;
      for (size_t i = (size_t)F.bid * NTHR + F.tid; i < n8; i += (size_t)F.G * NTHR) {
          const f32x4 a = ((const GAS f32x4*)F.x)[2 * i], b = ((const GAS f32x4*)F.x)[2 * i + 1];
          v4u o; o.x = pk2(a.x, a.y); o.y = pk2(a.z, a.w); o.z = pk2(b.x, b.y); o.w = pk2(b.z, b.w);
          ((GAS v4u*)F.XB)[i] = o; } }
    const int gt = F.bid * NTHR + F.tid;
    { bf16* WUPT = (bf16*)(F.wsb + WS_TAB + TABB_WUPT); bf16* AUPT = (bf16*)(F.wsb + WS_TAB + TABB_AUPT); bf16* GUPT = (bf16*)(F.wsb + WS_TAB + TABB_GUPT);
      for (int i = gt; i < 4 * 4 * 64 * 64; i += F.G * NTHR) { const int k = i & 63, c = (i >> 6) & 63, h = (i >> 12) & 3, l = i >> 14;
          WUPT[i] = (bf16)f2bf(F.w_up[((size_t)l * 64 + k) * 256 + h * 64 + c]); AUPT[i] = (bf16)f2bf(F.a_up[((size_t)l * 64 + k) * 256 + h * 64 + c]); }
      for (int i = gt; i < 4 * 4 * 64 * 128; i += F.G * NTHR) { const int k = i & 127, c = (i >> 7) & 63, h = (i >> 13) & 3, l = i >> 15;
          GUPT[i] = (bf16)f2bf(F.g_up[((size_t)l * 128 + k) * 256 + h * 64 + c]); } }
    if (gt < 3 * 8 * 129) {
        const int p = gt / 1032, h = (gt / 129) % 8, rel = gt % 129, dist = rel * (p == 0 ? 1 : (p == 1 ? 4 : 16));
        int b = dist;
        if (dist >= 16) { b = 16; b += dist >= 22; b += dist >= 30; b += dist >= 40; b += dist >= 54; b += dist >= 73; b += dist >= 99; b += dist >= 134; b += dist >= 182;
            b += dist >= 246; b += dist >= 332; b += dist >= 450; b += dist >= 609; b += dist >= 825; b += dist >= 1117; b += dist >= 1513; }
        F.TAB[TAB_BIAS + gt] = F.rel_bias[b * 8 + h];
    }
    for (int i = gt; i < SEQ * 32; i += F.G * NTHR) {
        const int pos = i >> 5, k = i & 31; double invd = 1.0;
        for (int q = 0; q < k; ++q) invd *= 0.7498942093324559;
        const float inv = (float)invd, ang = (float)pos * inv; float s, c; sincos_pos((double)ang, s, c);
        F.TAB[TAB_COS + i] = c; F.TAB[TAB_SIN + i] = s;
    }
}

__device__ __forceinline__ void unpack8(const v4u& a, float (&o)[8]) { o[0] = bflo(a.x); o[1] = bfhi(a.x); o[2] = bflo(a.y); o[3] = bfhi(a.y); o[4] = bflo(a.z); o[5] = bfhi(a.z); o[6] = bflo(a.w); o[7] = bfhi(a.w); }
#define LN_LOAD_GAINS float gv[16], bv[16]; \
    _Pragma("unroll") for (int j = 0; j < 2; ++j) _Pragma("unroll") for (int hh = 0; hh < 2; ++hh) { const f32x4 a = ((const GAS f32x4*)lg)[128 * j + 2 * F.lane + hh], b = ((const GAS f32x4*)lb)[128 * j + 2 * F.lane + hh]; \
            gv[8 * j + 4 * hh] = a.x; gv[8 * j + 4 * hh + 1] = a.y; gv[8 * j + 4 * hh + 2] = a.z; gv[8 * j + 4 * hh + 3] = a.w; \
            bv[8 * j + 4 * hh] = b.x; bv[8 * j + 4 * hh + 1] = b.y; bv[8 * j + 4 * hh + 2] = b.z; bv[8 * j + 4 * hh + 3] = b.w; }
template <int MODE, bool X32>
__device__ __forceinline__ void ph_ln(Frame& F, const float* x32, float* out32, const float* lg, const float* lb, const float* router, bf16* xb_out, bool dry, int lo_row = 0x7fffffff, const bf16* slab = nullptr, size_t slab_stride = 0, unsigned char* x8_out = nullptr) {
    constexpr int RG = (MODE == 0 && !X32) ? 8 : 4;
    GAS v4i* TI = (GAS v4i*)(F.TOK + TOK_TI); GAS f32x2* TG = (GAS f32x2*)(F.TOK + TOK_TG); GAS v2i* TP = (GAS v2i*)(F.TOK + TOK_TP); GAS int* CW = (GAS int*)(F.TOK + TOK_CW);
    for (int c = F.bid; c < T / 128; c += F.G) {
        int cnt[8];
#pragma unroll
        for (int e = 0; e < 8; ++e) cnt[e] = 0;
        const int tw = c * 128 + F.wave * 16;
        for (int grp = 0; grp < 16 / RG; ++grp) {
            v4u xa[RG][2], fa[RG][2], fb[RG][2]; f32x4 xf[RG][4]; f32x2 tgs[RG]; v2i tps[RG];
            if (MODE == 2) {
#pragma unroll
                for (int rr = 0; rr < RG; ++rr) { tps[rr] = TP[tw + grp * RG + rr]; tgs[rr] = TG[tw + grp * RG + rr]; }
#pragma unroll
                for (int rr = 0; rr < RG; ++rr) { const GAS v4u* y0 = (const GAS v4u*)(F.XG + (size_t)tps[rr].x * D) + F.lane; const GAS v4u* y1 = (const GAS v4u*)(F.XG + (size_t)tps[rr].y * D) + F.lane;
#pragma unroll
                    for (int j = 0; j < 2; ++j) { fa[rr][j] = y0[64 * j]; fb[rr][j] = y1[64 * j]; } } }
#pragma unroll
            for (int rr = 0; rr < RG; ++rr) { const int t = tw + grp * RG + rr;
                if (X32) { const GAS f32x4* xr = (const GAS f32x4*)(x32 + (size_t)t * D) + 2 * F.lane;
#pragma unroll
                    for (int j = 0; j < 2; ++j) { xf[rr][2 * j] = xr[128 * j]; xf[rr][2 * j + 1] = xr[128 * j + 1]; } }
                else { const GAS v4u* br = (const GAS v4u*)(F.XB + (size_t)t * D) + F.lane;
#pragma unroll
                    for (int j = 0; j < 2; ++j) xa[rr][j] = br[64 * j]; }
                if (MODE != 2) { const GAS v4u* hr = (const GAS v4u*)(F.HB + (size_t)t * D) + F.lane;
#pragma unroll
                    for (int j = 0; j < 2; ++j) fa[rr][j] = hr[64 * j]; } }
#pragma unroll
            for (int rr = 0; rr < RG; ++rr)
#pragma unroll
                for (int j = 0; j < 2; ++j) { if (X32) { PIN(xf[rr][2 * j]); PIN(xf[rr][2 * j + 1]); } else PIN(xa[rr][j]); PIN(fa[rr][j]); if (MODE == 2) PIN(fb[rr][j]); }
            float vn[MODE == 1 ? 4 : 1][16];
            { LN_LOAD_GAINS
#pragma unroll
            for (int rr = 0; rr < RG; ++rr) {
                const int t = tw + grp * RG + rr;
                float v[16];
#pragma unroll
                for (int j = 0; j < 2; ++j) {
                    float xx[8], ff[8];
                    if (X32) { xx[0] = xf[rr][2 * j].x; xx[1] = xf[rr][2 * j].y; xx[2] = xf[rr][2 * j].z; xx[3] = xf[rr][2 * j].w; xx[4] = xf[rr][2 * j + 1].x; xx[5] = xf[rr][2 * j + 1].y; xx[6] = xf[rr][2 * j + 1].z; xx[7] = xf[rr][2 * j + 1].w; }
                    else unpack8(xa[rr][j], xx);
                    unpack8(fa[rr][j], ff);
                    if (MODE == 2) { float f2[8]; unpack8(fb[rr][j], f2); const float g0 = tgs[rr].x, g1 = tgs[rr].y;
                        if (tps[rr].x >= lo_row) {
#pragma unroll
                            for (int k = 0; k < 8; ++k) ff[k] = 0.f;
                            for (int kp = 0; kp < 7; ++kp) { float t8[8]; const v4u sv = ((const GAS v4u*)(slab + (size_t)kp * slab_stride + (size_t)(tps[rr].x - lo_row) * D))[64 * j + F.lane]; unpack8(sv, t8);
#pragma unroll
                                for (int k = 0; k < 8; ++k) ff[k] += t8[k]; } }
                        if (tps[rr].y >= lo_row) {
#pragma unroll
                            for (int k = 0; k < 8; ++k) f2[k] = 0.f;
                            for (int kp = 0; kp < 7; ++kp) { float t8[8]; const v4u sv = ((const GAS v4u*)(slab + (size_t)kp * slab_stride + (size_t)(tps[rr].y - lo_row) * D))[64 * j + F.lane]; unpack8(sv, t8);
#pragma unroll
                                for (int k = 0; k < 8; ++k) f2[k] += t8[k]; } }
#pragma unroll
                        for (int k = 0; k < 8; ++k) v[8 * j + k] = ALPHA * xx[k] + g0 * ff[k] + g1 * f2[k]; }
                    else {
#pragma unroll
                        for (int k = 0; k < 8; ++k) v[8 * j + k] = ALPHA * xx[k] + ff[k]; } }
                float s = 0.f;
#pragma unroll
                for (int k = 0; k < 16; ++k) s += v[k];
                const float mean = wave_sum(s) * (1.f / D); float s2 = 0.f;
#pragma unroll
                for (int k = 0; k < 16; ++k) { v[k] -= mean; s2 += v[k] * v[k]; }
                const float rstd = __builtin_amdgcn_rsqf(wave_sum(s2) * (1.f / D) + LN_EPS);
#pragma unroll
                for (int k = 0; k < 16; ++k) v[k] = v[k] * rstd * gv[k] + bv[k];
                GAS v4u* brow = (GAS v4u*)(xb_out + (size_t)t * D) + F.lane;
#pragma unroll
                for (int j = 0; j < 2; ++j) { v4u o; o.x = pk2h(v[8 * j], v[8 * j + 1]); o.y = pk2h(v[8 * j + 2], v[8 * j + 3]); o.z = pk2h(v[8 * j + 4], v[8 * j + 5]); o.w = pk2h(v[8 * j + 6], v[8 * j + 7]); brow[64 * j] = o; }
                if (x8_out && !dry) { GAS v2u* xrow = (GAS v2u*)(x8_out + (size_t)t * D) + F.lane;
#pragma unroll
                    for (int j = 0; j < 2; ++j) { v2u o8; o8.x = pk4f8(v[8 * j], v[8 * j + 1], v[8 * j + 2], v[8 * j + 3], F8_XS); o8.y = pk4f8(v[8 * j + 4], v[8 * j + 5], v[8 * j + 6], v[8 * j + 7], F8_XS); xrow[64 * j] = o8; } }
                if (out32 && !dry) { GAS f32x4* orow = (GAS f32x4*)(out32 + (size_t)t * D) + 2 * F.lane;
#pragma unroll
                    for (int j = 0; j < 2; ++j) { orow[128 * j] = (f32x4){v[8 * j], v[8 * j + 1], v[8 * j + 2], v[8 * j + 3]}; orow[128 * j + 1] = (f32x4){v[8 * j + 4], v[8 * j + 5], v[8 * j + 6], v[8 * j + 7]}; } }
                if (MODE == 1) {
#pragma unroll
                    for (int k = 0; k < 16; ++k) vn[rr][k] = v[k]; }
            } }
            if (MODE == 1) {
                float lg[RG][8];
#pragma unroll
                for (int rr = 0; rr < RG; ++rr)
#pragma unroll
                    for (int e = 0; e < 8; ++e) lg[rr][e] = 0.f;
#pragma unroll
                for (int j = 0; j < 2; ++j) { const GAS f32x4* rp = (const GAS f32x4*)(router + (size_t)(512 * j + 8 * F.lane) * 8);
#pragma unroll
                    for (int k = 0; k < 8; ++k) { const f32x4 r0 = rp[2 * k], r1 = rp[2 * k + 1];
#pragma unroll
                        for (int rr = 0; rr < RG; ++rr) { const float xv = vn[rr][8 * j + k];
                            lg[rr][0] += xv * r0.x; lg[rr][1] += xv * r0.y; lg[rr][2] += xv * r0.z; lg[rr][3] += xv * r0.w; lg[rr][4] += xv * r1.x; lg[rr][5] += xv * r1.y; lg[rr][6] += xv * r1.z; lg[rr][7] += xv * r1.w; } } }
#pragma unroll
                for (int rr = 0; rr < RG; ++rr) { const int t = tw + grp * RG + rr;
                    float lg8[8];
#pragma unroll
                    for (int e = 0; e < 8; ++e) lg8[e] = wave_sum(lg[rr][e]);
                    int e0 = 0; float l0 = lg8[0];
#pragma unroll
                    for (int e = 1; e < 8; ++e) if (lg8[e] > l0) { l0 = lg8[e]; e0 = e; }
                    int e1 = -1; float l1 = -3.0e38f;
#pragma unroll
                    for (int e = 0; e < 8; ++e) if (e != e0 && lg8[e] > l1) { l1 = lg8[e]; e1 = e; }
                    const float g0 = 1.0f / (1.0f + __expf(l1 - l0)), g1 = 1.0f - g0;
                    int p0 = 0, p1 = 0;
#pragma unroll
                    for (int e = 0; e < 8; ++e) { if (e == e0) { p0 = cnt[e]; cnt[e] += 1; } if (e == e1) { p1 = cnt[e]; cnt[e] += 1; } }
                    if (F.lane == 0 && !dry) { TI[t] = (v4i){e0, e1, p0, p1}; TG[t] = (f32x2){g0, g1}; }
                }
            }
        }
        if (MODE == 1 && F.lane == 0 && !dry) {
#pragma unroll
            for (int e = 0; e < 8; ++e) CW[(c * 8 + F.wave) * 8 + e] = cnt[e];
        }
    }
}

__device__ __forceinline__ void ph_moe_gather(Frame& F) {
    LAS int* PS = (LAS int*)F.lds;
    LAS int* ST = PS + 512 * 8;
    LAS int* TOTL = ST + 64 * 8;
    GAS v4i* TI = (GAS v4i*)(F.TOK + TOK_TI); GAS v2i* TP = (GAS v2i*)(F.TOK + TOK_TP); GAS int* CW = (GAS int*)(F.TOK + TOK_CW);
    { int s[8];
#pragma unroll
      for (int e = 0; e < 8; ++e) s[e] = 0;
#pragma unroll
      for (int q = 0; q < 4; ++q) { const v4i a = *(const GAS v4i*)(CW + (F.tid * 4 + q) * 8), b = *(const GAS v4i*)(CW + (F.tid * 4 + q) * 8 + 4);
          s[0] += a.x; s[1] += a.y; s[2] += a.z; s[3] += a.w; s[4] += b.x; s[5] += b.y; s[6] += b.z; s[7] += b.w; }
#pragma unroll
      for (int e = 0; e < 8; ++e) PS[F.tid * 8 + e] = s[e]; }
    __syncthreads();
    { const int e = F.tid & 7, seg = F.tid >> 3; int run = 0;
#pragma unroll
      for (int i = 0; i < 8; ++i) { const int v = PS[(seg * 8 + i) * 8 + e]; PS[(seg * 8 + i) * 8 + e] = run; run += v; }
      ST[seg * 8 + e] = run; }
    __syncthreads();
    if (F.tid < 8) { int run = 0; for (int i = 0; i < 64; ++i) { const int v = ST[i * 8 + F.tid]; ST[i * 8 + F.tid] = run; run += v; } TOTL[F.tid] = run; }
    __syncthreads();
    if (F.tid == 0) { int ps = 0; for (int e = 0; e < 8; ++e) { const int pad = (TOTL[e] + 255) / 256 * 256; TOTL[8 + e] = ps; ps += pad; TOTL[16 + e] = ps; } }
    __syncthreads();
    if (F.bid == 0 && F.tid < 8) ((GAS int*)(F.TAB + TAB_META))[F.tid] = TOTL[16 + F.tid];
    for (int c = F.bid; c < T / 128; c += F.G) {
        int base[8];
#pragma unroll
        for (int e = 0; e < 8; ++e) { int b = TOTL[8 + e] + PS[(2 * c) * 8 + e] + ST[((2 * c) >> 3) * 8 + e];
            for (int w = 0; w < F.wave; ++w) b += CW[(c * 8 + w) * 8 + e];
            base[e] = b; }
        for (int grp = 0; grp < 4; ++grp) {
            v4i ti[4]; v4u ra[4], rb[4];
#pragma unroll
            for (int rr = 0; rr < 4; ++rr) { const int t = c * 128 + F.wave * 16 + grp * 4 + rr; ti[rr] = TI[t];
                const GAS v4u* src = (const GAS v4u*)(F.XB + (size_t)t * D) + F.lane; ra[rr] = src[0]; rb[rr] = src[64]; }
#pragma unroll
            for (int rr = 0; rr < 4; ++rr) { PIN(ra[rr]); PIN(rb[rr]); }
#pragma unroll
            for (int rr = 0; rr < 4; ++rr) { const int t = c * 128 + F.wave * 16 + grp * 4 + rr;
                int pos0 = ti[rr].z, pos1 = ti[rr].w;
#pragma unroll
                for (int e = 0; e < 8; ++e) { if (e == ti[rr].x) pos0 += base[e]; if (e == ti[rr].y) pos1 += base[e]; }
                if (MOE_GU_F8) {
                    v2u fa, fb; fa.x = pk4f8(bflo(ra[rr].x), bfhi(ra[rr].x), bflo(ra[rr].y), bfhi(ra[rr].y), F8_XS); fa.y = pk4f8(bflo(ra[rr].z), bfhi(ra[rr].z), bflo(ra[rr].w), bfhi(ra[rr].w), F8_XS);
                    fb.x = pk4f8(bflo(rb[rr].x), bfhi(rb[rr].x), bflo(rb[rr].y), bfhi(rb[rr].y), F8_XS); fb.y = pk4f8(bflo(rb[rr].z), bfhi(rb[rr].z), bflo(rb[rr].w), bfhi(rb[rr].w), F8_XS);
                    GAS v2u* e0 = (GAS v2u*)((unsigned char*)F.XG + (size_t)pos0 * D) + F.lane; GAS v2u* e1 = (GAS v2u*)((unsigned char*)F.XG + (size_t)pos1 * D) + F.lane;
                    e0[0] = fa; e0[64] = fb; e1[0] = fa; e1[64] = fb;
                } else {
                GAS v4u* d0 = (GAS v4u*)(F.XG + (size_t)pos0 * D) + F.lane; GAS v4u* d1 = (GAS v4u*)(F.XG + (size_t)pos1 * D) + F.lane;
                d0[0] = ra[rr]; d0[64] = rb[rr]; d1[0] = ra[rr]; d1[64] = rb[rr]; }
                if (F.lane == 0) TP[t] = (v2i){pos0, pos1}; }
        }
    }
    for (int i = F.bid * NWAVES + F.wave; i < NE * 256; i += F.G * NWAVES) {
        const int e = i >> 8, row = TOTL[8 + e] + TOTL[e] + (i & 255);
        if (row < TOTL[16 + e]) { if (MOE_GU_F8) { GAS v2u* d = (GAS v2u*)((unsigned char*)F.XG + (size_t)row * D) + F.lane; d[0] = (v2u){0u, 0u}; d[64] = (v2u){0u, 0u}; }
            else { GAS v4u* d = (GAS v4u*)(F.XG + (size_t)row * D) + F.lane; d[0] = (v4u){0u, 0u, 0u, 0u}; d[64] = (v4u){0u, 0u, 0u, 0u}; } }
    }
}

typedef short bf16x8 __attribute__((ext_vector_type(8)));
constexpr int ATT_KP = 144, ATT_VP = 272, ATT_KSLOT = 128 * ATT_KP, ATT_VSLOT = 64 * ATT_VP, ATT_VT_OFF = 3 * ATT_KSLOT, ATT_BIAS_OFF = ATT_VT_OFF + 3 * ATT_VSLOT;
constexpr int ATT_BT = 192, ATT_BT_OFF = 32;
static_assert(ATT_BIAS_OFF + 2 * ATT_BT * 4 <= RING_BYTES, "attention LDS map");
constexpr float LOG2E = 1.4426950408889634f, LN2 = 0.6931471805599453f;
constexpr int ATT_UNITS = NB * 8 * 96;
struct AttUnit { int b, h, p, d, r, n, chain; };
__device__ __forceinline__ AttUnit att_decode(int u) {
    AttUnit a; const int bh = u / 96, rem = u - bh * 96; a.p = rem >> 5; const int qq = rem & 31; a.b = bh >> 3; a.h = bh & 7;
    const int dsh = 2 * a.p, nbs = 5 - dsh; a.d = 1 << dsh; a.r = qq >> nbs; a.n = qq & ((1 << nbs) - 1); a.chain = u - a.n; return a;
}
__device__ __forceinline__ void att_load_block(const Frame& F, const AttUnit& a, int nblk, v4u (&kr)[2], v4u& va, v4u& vc) {
    const size_t seq0 = (size_t)a.b * SEQ;
#pragma unroll
    for (int k = 0; k < 2; ++k) { const int item = F.tid + NTHR * k, j = item >> 3, ch = item & 7;
        kr[k] = *(const GAS v4u*)(F.P + pix(seq0 + (size_t)(a.d * (128 * nblk + j) + a.r), C_AK + a.h * 64 + ch * 8)); }
    { const int kp = F.tid & 63, eo = F.tid >> 6; const size_t tok = seq0 + (size_t)(a.d * (128 * nblk + 2 * kp) + a.r);
      va = *(const GAS v4u*)(F.P + pix(tok, C_AV + a.h * 64 + eo * 8)); vc = *(const GAS v4u*)(F.P + pix(tok + a.d, C_AV + a.h * 64 + eo * 8)); }
}
__device__ __forceinline__ void att_store_block(const Frame& F, int slot, const v4u (&kr)[2], const v4u& a, const v4u& c) {
    LAS unsigned char* Ks = F.lds + slot * ATT_KSLOT; LAS unsigned char* Vt = F.lds + ATT_VT_OFF + slot * ATT_VSLOT;
#pragma unroll
    for (int k = 0; k < 2; ++k) { const int item = F.tid + NTHR * k, j = item >> 3, ch = item & 7; *(LAS v4u*)(Ks + j * ATT_KP + ch * 16) = kr[k]; }
    const int kp = F.tid & 63, eo = F.tid >> 6;
    LAS unsigned char* vb = Vt + (eo * 8) * ATT_VP + kp * 4;
    *(LAS unsigned*)(vb + 0 * ATT_VP) = (a.x & 0xffffu) | (c.x << 16); *(LAS unsigned*)(vb + 1 * ATT_VP) = (a.x >> 16) | (c.x & 0xffff0000u);
    *(LAS unsigned*)(vb + 2 * ATT_VP) = (a.y & 0xffffu) | (c.y << 16); *(LAS unsigned*)(vb + 3 * ATT_VP) = (a.y >> 16) | (c.y & 0xffff0000u);
    *(LAS unsigned*)(vb + 4 * ATT_VP) = (a.z & 0xffffu) | (c.z << 16); *(LAS unsigned*)(vb + 5 * ATT_VP) = (a.z >> 16) | (c.z & 0xffff0000u);
    *(LAS unsigned*)(vb + 6 * ATT_VP) = (a.w & 0xffffu) | (c.w << 16); *(LAS unsigned*)(vb + 7 * ATT_VP) = (a.w >> 16) | (c.w & 0xffff0000u);
}
__device__ __forceinline__ void att_compute(const Frame& F, const AttUnit& cu, size_t tq, bf16x8 bq0, bf16x8 bq1, bf16* OP, float* LSE, int sp, int sc, int bsel) {
    const LAS float* Bs = (const LAS float*)(F.lds + ATT_BIAS_OFF + bsel * ATT_BT * 4) + ATT_BT_OFF;
    const int lane = F.lane, w = F.wave, q = lane & 15, g = lane >> 4, i0 = 16 * w, n = cu.n;
    f32x4 o[4];
#pragma unroll
    for (int et = 0; et < 4; ++et) o[et] = zero4();
    float m = -1e30f, l = 0.f;
    const int c0 = w >> 1;
    for (int cc = 0; cc < 5; ++cc) {
        const int c = c0 + cc;
        if (n == 0 && c < 4) continue;
        const int slot = (c < 4) ? sp : sc, cl = c & 3;
        const LAS unsigned char* Ks = F.lds + slot * ATT_KSLOT; const LAS unsigned char* Vt = F.lds + ATT_VT_OFF + slot * ATT_VSLOT;
        bf16x8 ka[2][2], vf[4]; float bb[8];
        const int relb = i0 + q + 128 - (32 * c + 8 * g);
#pragma unroll
        for (int tt = 0; tt < 2; ++tt) { const int jrow = 32 * cl + 8 * (q >> 2) + 4 * tt + (q & 3);
            ka[tt][0] = *(const LAS bf16x8*)(Ks + jrow * ATT_KP + 16 * g); ka[tt][1] = *(const LAS bf16x8*)(Ks + jrow * ATT_KP + 64 + 16 * g); }
#pragma unroll
        for (int k = 0; k < 8; ++k) bb[k] = Bs[relb - k];
#pragma unroll
        for (int k = 0; k < 8; ++k) asm volatile("" : "+v"(bb[k]));
        __builtin_amdgcn_sched_barrier(0);
        f32x4 st[2];
#pragma unroll
        for (int tt = 0; tt < 2; ++tt) { f32x4 z = zero4();
            z = __builtin_amdgcn_mfma_f32_16x16x32_bf16(ka[tt][0], bq0, z, 0, 0, 0);
            st[tt] = __builtin_amdgcn_mfma_f32_16x16x32_bf16(ka[tt][1], bq1, z, 0, 0, 0); }
#pragma unroll
        for (int et = 0; et < 4; ++et) vf[et] = *(const LAS bf16x8*)(Vt + (16 * et + q) * ATT_VP + (32 * cl + 8 * g) * 2);
        float x[8]; float mx = -1e30f;
#pragma unroll
        for (int k = 0; k < 8; ++k) { const float v = st[k >> 2][k & 3] * (0.125f * LOG2E) + bb[k];
            x[k] = v; mx = fmaxf(mx, v); }
        mx = max_x4(mx);
        const float mn = fmaxf(m, mx), corr = __builtin_amdgcn_exp2f(m - mn); m = mn;
        float ps = 0.f;
#pragma unroll
        for (int k = 0; k < 8; ++k) { x[k] = __builtin_amdgcn_exp2f(x[k] - mn); ps += x[k]; }
        l = l * corr + ps;
#pragma unroll
        for (int et = 0; et < 4; ++et) o[et] = o[et] * corr;
        v4u pk; pk.x = pk2h(x[0], x[1]); pk.y = pk2h(x[2], x[3]); pk.z = pk2h(x[4], x[5]); pk.w = pk2h(x[6], x[7]);
        const bf16x8 pf = __builtin_bit_cast(bf16x8, pk);
#pragma unroll
        for (int et = 0; et < 4; ++et) o[et] = __builtin_amdgcn_mfma_f32_16x16x32_bf16(vf[et], pf, o[et], 0, 0, 0);
    }
    l = sum_x4(l);
    const float inv = __builtin_amdgcn_rcpf(l);
    bf16* orow = OP + ((size_t)cu.p * T + tq) * 512 + cu.h * 64 + 4 * g;
#pragma unroll
    for (int et = 0; et < 4; ++et) { v2u ov; ov.x = pk2h(o[et][0] * inv, o[et][1] * inv); ov.y = pk2h(o[et][2] * inv, o[et][3] * inv); *(GAS v2u*)(orow + 16 * et) = ov; }
    if (g == 0) LSE[((size_t)cu.p * T + tq) * 8 + cu.h] = (m + __builtin_amdgcn_logf(l)) * LN2;
}
struct AttSet { AttUnit u; v4u kr[2], va, vc; bf16x8 q0, q1; size_t tq; };
__device__ __forceinline__ void att_issue(const Frame& F, int u, AttSet& s) {
    s.u = att_decode(u); att_load_block(F, s.u, s.u.n, s.kr, s.va, s.vc);
    s.tq = (size_t)s.u.b * SEQ + (size_t)(s.u.d * (128 * s.u.n + 16 * F.wave + (F.lane & 15)) + s.u.r);
    const bf16* qp = F.P + pix(s.tq, C_AQ + s.u.h * 64 + 8 * (F.lane >> 4)); s.q0 = *(const GAS bf16x8*)qp; s.q1 = *(const GAS bf16x8*)(qp + 32);
}
__device__ __forceinline__ void ph_attn_mfma(Frame& F, bf16* OP, float* LSE) {
    const int upb = (ATT_UNITS + F.G - 1) / F.G, u0 = F.bid * upb, u1 = (u0 + upb < ATT_UNITS) ? u0 + upb : ATT_UNITS;
    if (u0 >= u1) return;
    AttSet cur, s1, s2;
    att_issue(F, u0, cur);
    att_store_block(F, 0, cur.kr, cur.va, cur.vc);
    if (cur.u.n > 0) { v4u kr[2], va, vc; att_load_block(F, cur.u, cur.u.n - 1, kr, va, vc); att_store_block(F, 2, kr, va, vc); }
    if (F.tid < ATT_BT) { const int rel = F.tid - ATT_BT_OFF; ((LAS float*)(F.lds + ATT_BIAS_OFF))[F.tid] = (rel >= 0 && rel <= 128) ? F.TAB[TAB_BIAS + (cur.u.p * 8 + cur.u.h) * 129 + rel] * LOG2E : -1e30f; }
    s1 = cur; s2 = cur;
    if (u0 + 1 < u1) att_issue(F, u0 + 1, s1);
    __syncthreads();
    int sc = 0, bsel = 0;
#define ATT_STEP(v, nxt, nxt2) { \
        if ((v) + 1 < u1) { att_store_block(F, (sc + 1) % 3, nxt.kr, nxt.va, nxt.vc); \
            if (F.tid < ATT_BT) { const int rel = F.tid - ATT_BT_OFF; ((LAS float*)(F.lds + ATT_BIAS_OFF + (bsel ^ 1) * ATT_BT * 4))[F.tid] = (rel >= 0 && rel <= 128) ? F.TAB[TAB_BIAS + (nxt.u.p * 8 + nxt.u.h) * 129 + rel] * LOG2E : -1e30f; } } \
        if ((v) + 2 < u1) att_issue(F, (v) + 2, nxt2); \
        att_compute(F, cur.u, cur.tq, cur.q0, cur.q1, OP, LSE, (sc + 2) % 3, sc, bsel); \
        __syncthreads(); \
        sc = (sc + 1) % 3; bsel ^= 1; \
        if ((v) + 1 < u1) { cur.u = nxt.u; cur.tq = nxt.tq; cur.q0 = nxt.q0; cur.q1 = nxt.q1; } }
    for (int u = u0; u < u1; u += 2) {
        ATT_STEP(u, s1, s2)
        if (u + 1 < u1) ATT_STEP(u + 1, s2, s1)
    }
#undef ATT_STEP
}
__device__ __forceinline__ void ph_attn_merge(Frame& F, const bf16* OP, const float* LSE) {
    const int wb = F.bid, nw = F.G;
    const int stride = nw * NTHR;
    for (int i0 = wb * NTHR + F.tid; i0 < T * 64; i0 += 4 * stride) {
        float l0[4], l1[4], l2[4]; v4u a[4], b[4], c[4]; int idx[4]; bool ok[4];
#pragma unroll
        for (int k = 0; k < 4; ++k) { const int ii = i0 + k * stride; ok[k] = ii < T * 64; idx[k] = ok[k] ? ii : i0;
            const int t = idx[k] >> 6, h = (idx[k] >> 3) & 7, ec = idx[k] & 7; const size_t off = (size_t)t * 512 + h * 64 + ec * 8;
            l0[k] = LSE[(size_t)t * 8 + h]; l1[k] = LSE[((size_t)T + t) * 8 + h]; l2[k] = LSE[((size_t)2 * T + t) * 8 + h];
            a[k] = *(const GAS v4u*)(OP + off); b[k] = *(const GAS v4u*)(OP + (size_t)T * 512 + off); c[k] = *(const GAS v4u*)(OP + (size_t)2 * T * 512 + off); }
#pragma unroll
        for (int k = 0; k < 4; ++k) { PIN(l0[k]); PIN(l1[k]); PIN(l2[k]); PIN(a[k]); PIN(b[k]); PIN(c[k]); }
#pragma unroll
        for (int k = 0; k < 4; ++k) {
            const int t = idx[k] >> 6, h = (idx[k] >> 3) & 7, ec = idx[k] & 7;
            const float mx = fmaxf(l0[k], fmaxf(l1[k], l2[k])); float w0 = __expf(l0[k] - mx), w1 = __expf(l1[k] - mx), w2 = __expf(l2[k] - mx);
            const float iw = __builtin_amdgcn_rcpf(w0 + w1 + w2); w0 *= iw; w1 *= iw; w2 *= iw;
            v4u o;
            o.x = pk2(w0 * bflo(a[k].x) + w1 * bflo(b[k].x) + w2 * bflo(c[k].x), w0 * bfhi(a[k].x) + w1 * bfhi(b[k].x) + w2 * bfhi(c[k].x));
            o.y = pk2(w0 * bflo(a[k].y) + w1 * bflo(b[k].y) + w2 * bflo(c[k].y), w0 * bfhi(a[k].y) + w1 * bfhi(b[k].y) + w2 * bfhi(c[k].y));
            o.z = pk2(w0 * bflo(a[k].z) + w1 * bflo(b[k].z) + w2 * bflo(c[k].z), w0 * bfhi(a[k].z) + w1 * bfhi(b[k].z) + w2 * bfhi(c[k].z));
            o.w = pk2(w0 * bflo(a[k].w) + w1 * bflo(b[k].w) + w2 * bflo(c[k].w), w0 * bfhi(a[k].w) + w1 * bfhi(b[k].w) + w2 * bfhi(c[k].w));
            if (ok[k]) *(GAS v4u*)(F.Y + (size_t)t * D + 256 + h * 64 + ec * 8) = o; }
    }
}

constexpr int RWP = 144, RWU = 64 * RWP;
constexpr int U_AT = 0, U_BT = 1, U_KT = 2, U_RT = 3, U_BHT = 4, U_KHT = 5, U_VT = 6, U_CT0 = 7, U_P0 = 9, U_PT0 = 10, U_NRB = 11, U_X = 12;
constexpr int U_CT1 = 0, U_P1 = 2, U_PT1 = 12, U_MV = 9, U_EKT = 10;
constexpr int RW_LW = 9 * RWU, RW_AA = RW_LW + 16384, RW_SEG = 13 * RWU, RW_WL = RW_SEG + 2048;
static_assert(RW_AA + 16384 <= 13 * RWU && RW_WL + 768 + 8192 <= RING_BYTES && MISC_OFF + 1024 + 8192 <= LDS_BYTES, "rwkv LDS map");
constexpr size_t RWS_QEFF = 0, RWS_GP = 16 * MiB, RWS_HLOC = 32 * MiB, RWS_YLOC = 64 * MiB, RWS_BV = 96 * MiB, RWS_Z0T = 128 * MiB, RWS_BYTES = 144 * MiB;

__device__ __forceinline__ f32x4 gram_tile(const LAS unsigned char* A, int ra0, const LAS unsigned char* B, int rb0, int q, int g, f32x4 acc) {
    const LAS unsigned char* ap = A + (ra0 + q) * RWP + 16 * g; const LAS unsigned char* bp = B + (rb0 + q) * RWP + 16 * g;
    const bf16x8 a0 = *(const LAS bf16x8*)ap, a1 = *(const LAS bf16x8*)(ap + 64), b0 = *(const LAS bf16x8*)bp, b1 = *(const LAS bf16x8*)(bp + 64);
    acc = __builtin_amdgcn_mfma_f32_16x16x32_bf16(a0, b0, acc, 0, 0, 0);
    return __builtin_amdgcn_mfma_f32_16x16x32_bf16(a1, b1, acc, 0, 0, 0);
}
__device__ __forceinline__ void store_t(LAS unsigned char* OUT, int ra0, int rb0, int q, int g, f32x4 v) {
    v2u o; o.x = pk2(v[0], v[1]); o.y = pk2(v[2], v[3]); *(LAS v2u*)(OUT + (rb0 + q) * RWP + (ra0 + 4 * g) * 2) = o;
}
__device__ __forceinline__ f32x4 load_t(const LAS unsigned char* IN, int ra0, int rb0, int q, int g) {
    const v2u o = *(const LAS v2u*)(IN + (rb0 + q) * RWP + (ra0 + 4 * g) * 2); return (f32x4){bflo(o.x), bfhi(o.x), bflo(o.y), bfhi(o.y)};
}
__device__ __forceinline__ void load_mix8(const bf16* P, size_t tok, bool first, int col, const float* mu, float (&o)[8]) {
    const v4u c = *(const GAS v4u*)(P + pix(tok, col)); v4u pv = *(const GAS v4u*)(P + pix(first ? tok : tok - 1, col));
    if (first) pv = (v4u){0u, 0u, 0u, 0u};
    const f32x4 m0 = *(const GAS f32x4*)(mu + col), m1 = *(const GAS f32x4*)(mu + col + 4);
    o[0] = bflo(c.x) + (bflo(pv.x) - bflo(c.x)) * m0.x; o[1] = bfhi(c.x) + (bfhi(pv.x) - bfhi(c.x)) * m0.y;
    o[2] = bflo(c.y) + (bflo(pv.y) - bflo(c.y)) * m0.z; o[3] = bfhi(c.y) + (bfhi(pv.y) - bfhi(c.y)) * m0.w;
    o[4] = bflo(c.z) + (bflo(pv.z) - bflo(c.z)) * m1.x; o[5] = bfhi(c.z) + (bfhi(pv.z) - bfhi(c.z)) * m1.y;
    o[6] = bflo(c.w) + (bflo(pv.w) - bflo(c.w)) * m1.z; o[7] = bfhi(c.w) + (bfhi(pv.w) - bfhi(c.w)) * m1.w;
}
__device__ __forceinline__ bf16x8 pack8(const float (&x)[8]) { v4u p; p.x = pk2(x[0], x[1]); p.y = pk2(x[2], x[3]); p.z = pk2(x[4], x[5]); p.w = pk2(x[6], x[7]); return __builtin_bit_cast(bf16x8, p); }

__device__ __forceinline__ void r1_issue(const Frame& F, int ch, v4u (&dxc)[4], v4u (&dxp)[4], unsigned (&draw)[27]) {
    const int lane = F.lane, w = F.wave, q = lane & 15, g = lane >> 4;
    const int bh = ch >> 6, chunk = ch & 63, b = bh >> 2, h = bh & 3;
    const size_t tok0 = (size_t)b * SEQ + chunk * 64;
    { const int rt = w >> 1; const size_t tok = tok0 + 16 * rt + q; const bool first = (chunk == 0 && rt == 0 && q == 0);
#pragma unroll
      for (int i = 0; i < 4; ++i) { const int col = 768 + 32 * i + 8 * g; dxc[i] = *(const GAS v4u*)(F.P + pix(tok, col)); dxp[i] = *(const GAS v4u*)(F.P + pix(first ? tok : tok - 1, col)); } }
    { const int cg = h * 64 + lane; const size_t tokb = tok0 + 8 * w; const bool hasprev = !(chunk == 0 && w == 0);
      { const bf16* pp = F.P + pix(hasprev ? tokb - 1 : tokb, cg); draw[0] = pp[0]; draw[1] = pp[4 * PLANE]; draw[2] = pp[8 * PLANE]; }
#pragma unroll
      for (int j = 0; j < 8; ++j) { const bf16* pp = F.P + pix(tokb + j, cg); draw[3 * j + 3] = pp[0]; draw[3 * j + 4] = pp[4 * PLANE]; draw[3 * j + 5] = pp[8 * PLANE]; } }
}
__device__ __forceinline__ void r1_mix8(const v4u& c, const v4u& pv, const LAS float* mul, int col, float (&o)[8]) {
    const f32x4 m0 = *(const LAS f32x4*)(mul + col - 768), m1 = *(const LAS f32x4*)(mul + col - 768 + 4);
    o[0] = bflo(c.x) + (bflo(pv.x) - bflo(c.x)) * m0.x; o[1] = bfhi(c.x) + (bfhi(pv.x) - bfhi(c.x)) * m0.y;
    o[2] = bflo(c.y) + (bflo(pv.y) - bflo(c.y)) * m0.z; o[3] = bfhi(c.y) + (bfhi(pv.y) - bfhi(c.y)) * m0.w;
    o[4] = bflo(c.z) + (bflo(pv.z) - bflo(c.z)) * m1.x; o[5] = bfhi(c.z) + (bfhi(pv.z) - bfhi(c.z)) * m1.y;
    o[6] = bflo(c.w) + (bflo(pv.w) - bflo(c.w)) * m1.z; o[7] = bfhi(c.w) + (bfhi(pv.w) - bfhi(c.w)) * m1.w;
}
__device__ __forceinline__ void ph_rwkv_r1(Frame& F, int l, unsigned char* RWS) {
    LAS unsigned char* L = F.lds;
    const int lane = F.lane, w = F.wave, q = lane & 15, g = lane >> 4;
    const float* mu = F.mu + l * 1024;
    const bf16* WUPT = (const bf16*)(F.wsb + WS_TAB + TABB_WUPT); const bf16* AUPT = (const bf16*)(F.wsb + WS_TAB + TABB_AUPT);
    bf16* QEFF = (bf16*)(RWS + RWS_QEFF); bf16* GP = (bf16*)(RWS + RWS_GP); float* HLOC = (float*)(RWS + RWS_HLOC); float* YLOC = (float*)(RWS + RWS_YLOC); float* BV = (float*)(RWS + RWS_BV);
    LAS float* LW = (LAS float*)(L + RW_LW); LAS float* AA = (LAS float*)(L + RW_AA); LAS float* SEG = (LAS float*)(L + RW_SEG); LAS float* WL = (LAS float*)(L + RW_WL);
    if (F.bid >= NB * 4 * 64) return;
    LAS float* MUL = (LAS float*)(L + RW_WL + 256);
    if (F.tid < 128) MUL[F.tid] = mu[768 + F.tid];
    __syncthreads();
    int hcur = -1; float hw0[2] = {0.f, 0.f}, ha0[2] = {0.f, 0.f}, hmur = 0.f, hmuk = 0.f, hmuv = 0.f, hkk = 0.f, hka = 0.f, hrk = 0.f;
    LAS unsigned char* HW = L + RW_WL + 768;
    LAS unsigned char* HA = L + MISC_OFF + 1024;
    v4u pxc[4], pxp[4]; unsigned praw[27]; r1_issue(F, F.bid, pxc, pxp, praw);
    for (int ch = F.bid; ch < NB * 4 * 64; ch += F.G) {
        const int bh = ch >> 6, chunk = ch & 63, b = bh >> 2, h = bh & 3;
        const size_t tok0 = (size_t)b * SEQ + chunk * 64;
        v4u cxc[4], cxp[4]; unsigned raw[27];
#pragma unroll
        for (int i = 0; i < 4; ++i) { cxc[i] = pxc[i]; cxp[i] = pxp[i]; PIN(cxc[i]); PIN(cxp[i]); }
#pragma unroll
        for (int k = 0; k < 27; ++k) { raw[k] = praw[k]; PIN(raw[k]); }
        if (ch + F.G < NB * 4 * 64) r1_issue(F, ch + F.G, pxc, pxp, praw);
        if (h != hcur) { hcur = h;
            *(LAS v4u*)(HW + F.tid * 16) = *(const GAS v4u*)(WUPT + (size_t)(l * 4 + h) * 4096 + F.tid * 8); *(LAS v4u*)(HA + F.tid * 16) = *(const GAS v4u*)(AUPT + (size_t)(l * 4 + h) * 4096 + F.tid * 8);
#pragma unroll
            for (int k = 0; k < 2; ++k) { const int c = 16 * (2 * (w & 1) + k) + q; hw0[k] = F.w0[l * 256 + h * 64 + c]; ha0[k] = F.a0[l * 256 + h * 64 + c]; }
            { const int cg = h * 64 + lane; hmur = mu[cg]; hmuk = mu[256 + cg]; hmuv = mu[512 + cg]; hkk = F.k_k[l * 256 + cg]; hka = F.k_a[l * 256 + cg]; hrk = F.r_k[l * 256 + cg]; }
            __syncthreads(); }
        { const int rt = w >> 1; const bool first = (chunk == 0 && rt == 0 && q == 0);
          if (first) {
#pragma unroll
              for (int i = 0; i < 4; ++i) cxp[i] = (v4u){0u, 0u, 0u, 0u}; }
          float xw0[8], xw1[8], xa0[8], xa1[8];
          r1_mix8(cxc[0], cxp[0], MUL, 768 + 8 * g, xw0); r1_mix8(cxc[1], cxp[1], MUL, 800 + 8 * g, xw1);
          r1_mix8(cxc[2], cxp[2], MUL, 832 + 8 * g, xa0); r1_mix8(cxc[3], cxp[3], MUL, 864 + 8 * g, xa1);
#pragma unroll
          for (int i = 0; i < 8; ++i) { xw0[i] = 1.0f - 2.0f * __builtin_amdgcn_rcpf(__expf(2.0f * xw0[i]) + 1.0f); xw1[i] = 1.0f - 2.0f * __builtin_amdgcn_rcpf(__expf(2.0f * xw1[i]) + 1.0f); }
          const bf16x8 aw0 = pack8(xw0), aw1 = pack8(xw1), aa0 = pack8(xa0), aa1 = pack8(xa1);
#pragma unroll
          for (int k = 0; k < 2; ++k) { const int ct = 2 * (w & 1) + k, c = 16 * ct + q;
              const bf16x8 bw0 = *(const LAS bf16x8*)(HW + c * 128 + 16 * g), bw1 = *(const LAS bf16x8*)(HW + c * 128 + 64 + 16 * g), ba0 = *(const LAS bf16x8*)(HA + c * 128 + 16 * g), ba1 = *(const LAS bf16x8*)(HA + c * 128 + 64 + 16 * g);
              const float w0c_ = hw0[k], a0c_ = ha0[k];
              f32x4 dw = zero4(), da = zero4();
              dw = __builtin_amdgcn_mfma_f32_16x16x32_bf16(aw0, bw0, dw, 0, 0, 0); dw = __builtin_amdgcn_mfma_f32_16x16x32_bf16(aw1, bw1, dw, 0, 0, 0);
              da = __builtin_amdgcn_mfma_f32_16x16x32_bf16(aa0, ba0, da, 0, 0, 0); da = __builtin_amdgcn_mfma_f32_16x16x32_bf16(aa1, ba1, da, 0, 0, 0);
#pragma unroll
              for (int r = 0; r < 4; ++r) { const int t = 16 * rt + 4 * g + r; LW[t * 64 + c] = -0.6065306597126334f * sigm(w0c_ + dw[r]); AA[t * 64 + c] = sigm(a0c_ + da[r]); } } }
        __syncthreads();
        { const int c = lane, cg = h * 64 + c;
          const float mur = hmur, muk = hmuk, muv = hmuv;
          const float kkc = hkk, kac = hka, rkc = hrk;
          const bool hasprev = !(chunk == 0 && w == 0);
          float pr = hasprev ? bflo(raw[0]) : 0.f, pk = hasprev ? bflo(raw[1]) : 0.f, pv = hasprev ? bflo(raw[2]) : 0.f;
          float rr[8], kk2[8], vv[8], al[8], bb[8], cum[8], lws[8];
          float run = 0.f;
#pragma unroll
          for (int j = 0; j < 8; ++j) { const float cr = bflo(raw[3 * j + 3]), ck = bflo(raw[3 * j + 4]), cv = bflo(raw[3 * j + 5]);
              const float r_ = cr + (pr - cr) * mur, k_ = ck + (pk - ck) * muk, v_ = cv + (pv - cv) * muv; pr = cr; pk = ck; pv = cv;
              const int t = 8 * w + j; const float a_ = AA[t * 64 + c], lw = LW[t * 64 + c];
              const float kx = k_ * kkc, nn = wave_sum(kx * kx), kap = kx * __builtin_amdgcn_rsqf(fmaxf(nn, 1e-24f));
              const float kp = k_ * (1.0f + (a_ - 1.0f) * kac);
              const float bon = wave_sum(r_ * kp * rkc);
              rr[j] = r_; kk2[j] = kp; vv[j] = v_; al[j] = -kap; bb[j] = kap * a_; run += lw; cum[j] = run; lws[j] = lw;
              BV[(((size_t)ch * 16 + (w >> 1) * 4 + (c >> 4)) * 64 + (2 * (w & 1) + (j >> 2)) * 16 + (c & 15)) * 4 + (j & 3)] = bon * v_; }
          SEG[w * 64 + c] = run;
          __syncthreads();
          float off = 0.f, tot = 0.f;
#pragma unroll
          for (int ww = 0; ww < 8; ++ww) { const float s = SEG[ww * 64 + c]; tot += s; if (ww < w) off += s; }
          if (w == 0) WL[c] = __expf(tot);
          float at_[8], bt_[8], kt_[8], rt_[8], bh_[8], kh_[8];
#pragma unroll
          for (int j = 0; j < 8; ++j) { const float cu = off + cum[j], em = __expf(-cu), ep = __expf(cu), eh = __expf(tot - cu), epv = __expf(cu - lws[j]);
              at_[j] = al[j] * epv; bt_[j] = bb[j] * em; kt_[j] = kk2[j] * em; rt_[j] = rr[j] * ep; bh_[j] = bb[j] * eh; kh_[j] = kk2[j] * eh; }
#pragma unroll
          for (int j = 0; j < 8; ++j) { const int t = 8 * w + j;
              *(LAS bf16*)(L + U_AT * RWU + t * RWP + c * 2) = (bf16)f2bf(at_[j]); *(LAS bf16*)(L + U_BT * RWU + t * RWP + c * 2) = (bf16)f2bf(bt_[j]);
              *(LAS bf16*)(L + U_KT * RWU + t * RWP + c * 2) = (bf16)f2bf(kt_[j]); *(LAS bf16*)(L + U_RT * RWU + t * RWP + c * 2) = (bf16)f2bf(rt_[j]); }
          *(LAS bf16x8*)(L + U_CT0 * RWU + c * RWP + 16 * w) = pack8(at_);
          *(LAS bf16x8*)(L + U_BHT * RWU + c * RWP + 16 * w) = pack8(bh_);
          *(LAS bf16x8*)(L + U_KHT * RWU + c * RWP + 16 * w) = pack8(kh_);
          *(LAS bf16x8*)(L + U_VT * RWU + c * RWP + 16 * w) = pack8(vv); }
        __syncthreads();
        const int ra0 = 16 * (w >> 1);
#define RW_FRAG(f, unit, row0) { const LAS unsigned char* p_ = L + (unit) * RWU + ((row0) + q) * RWP + 16 * g; f[0] = *(const LAS bf16x8*)p_; f[1] = *(const LAS bf16x8*)(p_ + 64); }
#define RW_MM(acc, fa, fb) { acc = __builtin_amdgcn_mfma_f32_16x16x32_bf16(fa[0], fb[0], acc, 0, 0, 0); acc = __builtin_amdgcn_mfma_f32_16x16x32_bf16(fa[1], fb[1], acc, 0, 0, 0); }
        f32x4 nrk[2];
#pragma unroll
        for (int k = 0; k < 2; ++k) { const int rb0 = 16 * (2 * (w & 1) + k);
            bf16x8 fat[2], fbt[2], fkt[2], gb[2], ga[2], gk[2], gr[2];
            RW_FRAG(fat, U_AT, ra0) RW_FRAG(fbt, U_BT, ra0) RW_FRAG(fkt, U_KT, ra0)
            RW_FRAG(gb, U_BT, rb0) RW_FRAG(ga, U_AT, rb0) RW_FRAG(gk, U_KT, rb0)
            __builtin_amdgcn_sched_barrier(0);
            f32x4 d1 = zero4(), d2 = zero4(), d3 = zero4(), d4 = zero4(), d5 = zero4();
            RW_MM(d1, fat, gb)
            RW_MM(d2, fbt, ga)
            RW_MM(d3, fat, gk)
            RW_FRAG(gr, U_RT, rb0)
            RW_MM(d4, fbt, gr)
            RW_MM(d5, fkt, gr)
#pragma unroll
            for (int r = 0; r < 4; ++r) { const int row = ra0 + 4 * g + r, col = rb0 + q;
                if (!(col < row)) { d1[r] = 0.f; d3[r] = 0.f; } if (!(row < col)) d2[r] = 0.f; if (!(row <= col)) d4[r] = 0.f; }
            store_t(L + U_PT0 * RWU, ra0, rb0, q, g, d1); store_t(L + U_P0 * RWU, ra0, rb0, q, g, d2);
            store_t(L + (U_CT0 + 1) * RWU, ra0, rb0, q, g, d3); store_t(L + U_NRB * RWU, ra0, rb0, q, g, d4); nrk[k] = d5;
            __builtin_amdgcn_sched_barrier(0); }
        __syncthreads();
#pragma unroll
        for (int st = 0; st < 3; ++st) {
            const int uP = (st & 1) ? U_P1 : U_P0, uPT = (st & 1) ? U_PT1 : U_PT0, uC = (st & 1) ? U_CT1 : U_CT0;
            const int uPn = (st & 1) ? U_P0 : U_P1, uPTn = (st & 1) ? U_PT0 : U_PT1, uCn = (st & 1) ? U_CT0 : U_CT1;
            bf16x8 fp[2], fpt[2];
            RW_FRAG(fp, uP, ra0)
#pragma unroll
            for (int kk = 0; kk < 2; ++kk) { bf16x8 fc[2][2]; f32x4 add[2];
#pragma unroll
                for (int k = 0; k < 2; ++k) { const int rb0 = 16 * (4 * (w & 1) + 2 * kk + k); RW_FRAG(fc[k], uC, rb0) add[k] = load_t(L + uC * RWU, ra0, rb0, q, g); }
                __builtin_amdgcn_sched_barrier(0);
#pragma unroll
                for (int k = 0; k < 2; ++k) { const int rb0 = 16 * (4 * (w & 1) + 2 * kk + k); f32x4 d = add[k]; RW_MM(d, fp, fc[k]) store_t(L + uCn * RWU, ra0, rb0, q, g, d); }
                __builtin_amdgcn_sched_barrier(0); }
            if (st < 2) { bf16x8 gp[2][2], gpt[2][2];
                RW_FRAG(fpt, uPT, ra0)
#pragma unroll
                for (int k = 0; k < 2; ++k) { const int rb0 = 16 * (2 * (w & 1) + k); RW_FRAG(gpt[k], uPT, rb0) RW_FRAG(gp[k], uP, rb0) }
                __builtin_amdgcn_sched_barrier(0);
#pragma unroll
                for (int k = 0; k < 2; ++k) { const int rb0 = 16 * (2 * (w & 1) + k);
                    f32x4 e1 = zero4(), e2 = zero4();
                    RW_MM(e1, fp, gpt[k]) store_t(L + uPTn * RWU, ra0, rb0, q, g, e1);
                    RW_MM(e2, fpt, gp[k]) store_t(L + uPn * RWU, ra0, rb0, q, g, e2); } }
            __syncthreads();
        }
#pragma unroll
        for (int k = 0; k < 2; ++k) { const int rb0 = 16 * (2 * (w & 1) + k);
            bf16x8 fah[2], ftm[2], gn[2], gh[2];
            RW_FRAG(fah, U_CT1, ra0) RW_FRAG(ftm, U_CT1 + 1, ra0) RW_FRAG(gn, U_NRB, rb0) RW_FRAG(gh, U_BHT, rb0)
            const f32x4 ar = load_t(L + U_RT * RWU, ra0, rb0, q, g), ak = load_t(L + U_KHT * RWU, ra0, rb0, q, g); const float wl = WL[rb0 + q];
            __builtin_amdgcn_sched_barrier(0);
            { f32x4 d = ar; RW_MM(d, fah, gn)
              v2u o; o.x = pk2h(d[0], d[1]); o.y = pk2h(d[2], d[3]);
              *(GAS v2u*)(QEFF + (tok0 + rb0 + q) * 256 + h * 64 + ra0 + 4 * g) = o; }
            { f32x4 d = zero4(); RW_MM(d, fah, gh)
#pragma unroll
              for (int r = 0; r < 4; ++r) if (ra0 + 4 * g + r == rb0 + q) d[r] += wl;
              v2u o; o.x = pk2h(d[0], d[1]); o.y = pk2h(d[2], d[3]);
              const int tau = ra0 >> 4;
              *(GAS v2u*)(GP + ((size_t)ch * 64 + rb0 + q) * 64 + 32 * (tau >> 1) + 8 * g + 4 * (tau & 1)) = o; }
            { f32x4 d = nrk[k]; RW_MM(d, ftm, gn)
#pragma unroll
              for (int r = 0; r < 4; ++r) if (!(ra0 + 4 * g + r <= rb0 + q)) d[r] = 0.f;
              store_t(L + U_MV * RWU, ra0, rb0, q, g, d); }
            { f32x4 d = ak; RW_MM(d, ftm, gh)
              store_t(L + U_EKT * RWU, ra0, rb0, q, g, d); }
            __builtin_amdgcn_sched_barrier(0); }
        __syncthreads();
        { bf16x8 fmv[2], fek[2], gv[2][2];
          RW_FRAG(fmv, U_MV, ra0) RW_FRAG(fek, U_EKT, ra0)
#pragma unroll
          for (int k = 0; k < 2; ++k) { const int rb0 = 16 * (2 * (w & 1) + k); RW_FRAG(gv[k], U_VT, rb0) }
          __builtin_amdgcn_sched_barrier(0);
#pragma unroll
          for (int k = 0; k < 2; ++k) { const int ti = 2 * w + k;
              f32x4 y = zero4(), hh = zero4();
              RW_MM(y, fmv, gv[k]) *(GAS f32x4*)(YLOC + (((size_t)ch * 16 + ti) * 64 + lane) * 4) = y;
              RW_MM(hh, fek, gv[k]) *(GAS f32x4*)(HLOC + (((size_t)ch * 16 + ti) * 64 + lane) * 4) = hh; } }
#undef RW_FRAG
#undef RW_MM
        __syncthreads();
    }
}
__device__ __forceinline__ void ph_rwkv_r2(Frame& F, unsigned char* RWS) {
    const bf16* GP = (const bf16*)(RWS + RWS_GP); const float* HLOC = (const float*)(RWS + RWS_HLOC); bf16* Z0T = (bf16*)(RWS + RWS_Z0T);
    const int lane = F.lane, q = lane & 15, g = lane >> 4;
    constexpr int PD = 4;
    for (int task = F.bid + (F.wave ? 128 : 0); task < 128; task += F.G) {
        const int bh = task >> 2, ig = task & 3;
        f32x4 z[4];
#pragma unroll
        for (int t = 0; t < 4; ++t) z[t] = zero4();
        bf16x8 ga[PD][4][2]; f32x4 hl[PD][4];
        const bf16* gbase = GP + ((size_t)bh * 64 * 64 + q) * 64 + 8 * g; const float* hbase = HLOC + (((size_t)bh * 64 * 16 + ig) * 64 + lane) * 4;
#pragma unroll
        for (int k = 0; k < PD; ++k)
#pragma unroll
            for (int t = 0; t < 4; ++t) { const bf16* gp = gbase + ((size_t)k * 64 + 16 * t) * 64; ga[k][t][0] = *(const GAS bf16x8*)gp; ga[k][t][1] = *(const GAS bf16x8*)(gp + 32);
                hl[k][t] = *(const GAS f32x4*)(hbase + ((size_t)k * 16 + t * 4) * 256); }
        for (int c4 = 0; c4 < 64; c4 += PD) {
#pragma unroll
            for (int k = 0; k < PD; ++k) {
                const int chunk = c4 + k; const size_t ch = (size_t)bh * 64 + chunk;
                v2u pz[4];
#pragma unroll
                for (int t = 0; t < 4; ++t) { pz[t].x = pk2(z[t][0], z[t][1]); pz[t].y = pk2(z[t][2], z[t][3]); *(GAS v2u*)(Z0T + (ch * 64 + 16 * ig + q) * 64 + 16 * t + 4 * g) = pz[t]; }
                const bf16x8 b0 = __builtin_bit_cast(bf16x8, (v4u){pz[0].x, pz[0].y, pz[1].x, pz[1].y}), b1 = __builtin_bit_cast(bf16x8, (v4u){pz[2].x, pz[2].y, pz[3].x, pz[3].y});
#pragma unroll
                for (int t = 0; t < 4; ++t) { const f32x4 acc = __builtin_amdgcn_mfma_f32_16x16x32_bf16(ga[k][t][0], b0, hl[k][t], 0, 0, 0);
                    z[t] = __builtin_amdgcn_mfma_f32_16x16x32_bf16(ga[k][t][1], b1, acc, 0, 0, 0); }
                if (chunk + PD < 64) {
#pragma unroll
                    for (int t = 0; t < 4; ++t) { const bf16* gp = gbase + ((size_t)(chunk + PD) * 64 + 16 * t) * 64; ga[k][t][0] = *(const GAS bf16x8*)gp; ga[k][t][1] = *(const GAS bf16x8*)(gp + 32);
                        hl[k][t] = *(const GAS f32x4*)(hbase + ((size_t)(chunk + PD) * 16 + t * 4) * 256); } }
            }
        }
    }
}
__device__ __forceinline__ void ph_rwkv_r3(Frame& F, int l, unsigned char* RWS) {
    const bf16* QEFF = (const bf16*)(RWS + RWS_QEFF); const float* YLOC = (const float*)(RWS + RWS_YLOC); const float* BV = (const float*)(RWS + RWS_BV); const bf16* Z0T = (const bf16*)(RWS + RWS_Z0T);
    const bf16* GUPT = (const bf16*)(F.wsb + WS_TAB + TABB_GUPT);
    const float* mu = F.mu + l * 1024;
    const int lane = F.lane, q = lane & 15, g = lane >> 4;
    constexpr int R3_GP = 272, R3_MU = 64 * R3_GP, R3_LG = R3_MU + 512, R3_LB = R3_LG + 256;
    LAS unsigned char* GT = F.lds; LAS float* MU3 = (LAS float*)(F.lds + R3_MU); LAS float* LG = (LAS float*)(F.lds + R3_LG); LAS float* LB = (LAS float*)(F.lds + R3_LB);
    int hcur = -1;
    for (int task = F.bid * NWAVES + F.wave; task < NB * 4 * 64 * 4; task += F.G * NWAVES) {
        const int ch = task >> 2, rt = task & 3, bh = ch >> 6, chunk = ch & 63, b = bh >> 2, h = bh & 3;
        const size_t tok0 = (size_t)b * SEQ + chunk * 64 + 16 * rt;
        if (h != hcur) {
            if (hcur >= 0) __syncthreads();
            hcur = h;
#pragma unroll
            for (int i = 0; i < 2; ++i) { const int e = F.tid * 2 + i, c = e >> 4, part = e & 15;
                *(LAS v4u*)(GT + c * R3_GP + part * 16) = *(const GAS v4u*)(GUPT + ((size_t)(l * 4 + h) * 64 + c) * 128 + part * 8); }
            if (F.tid < 128) MU3[F.tid] = mu[896 + F.tid];
            if (F.tid < 64) { LG[F.tid] = F.rln_g[l * 256 + h * 64 + F.tid]; LB[F.tid] = F.rln_b[l * 256 + h * 64 + F.tid]; }
            __syncthreads(); }
        const bf16* qp = QEFF + (tok0 + q) * 256 + h * 64 + 8 * g;
        bf16x8 a0 = *(const GAS bf16x8*)qp, a1 = *(const GAS bf16x8*)(qp + 32);
        v4u xc[4], xp[4]; bf16x8 zb[4][2]; f32x4 yl[4], bvv[4];
        const bool first = (chunk == 0 && rt == 0 && q == 0);
#pragma unroll
        for (int s = 0; s < 4; ++s) { const int col = 896 + 32 * s + 8 * g; xc[s] = *(const GAS v4u*)(F.P + pix(tok0 + q, col)); xp[s] = *(const GAS v4u*)(F.P + pix(first ? tok0 + q : tok0 + q - 1, col)); }
#pragma unroll
        for (int ct = 0; ct < 4; ++ct) { const bf16* zp = Z0T + ((size_t)ch * 64 + 16 * ct + q) * 64 + 8 * g; zb[ct][0] = *(const GAS bf16x8*)zp; zb[ct][1] = *(const GAS bf16x8*)(zp + 32);
            yl[ct] = *(const GAS f32x4*)(YLOC + (((size_t)ch * 16 + rt * 4 + ct) * 64 + lane) * 4);
            bvv[ct] = *(const GAS f32x4*)(BV + (((size_t)ch * 16 + rt * 4 + ct) * 64 + lane) * 4); }
        PIN(a0); PIN(a1);
#pragma unroll
        for (int s = 0; s < 4; ++s) { PIN(xc[s]); PIN(xp[s]); if (first) xp[s] = (v4u){0u, 0u, 0u, 0u}; }
#pragma unroll
        for (int ct = 0; ct < 4; ++ct) { PIN(zb[ct][0]); PIN(zb[ct][1]); PIN(yl[ct]); PIN(bvv[ct]); }
        bf16x8 ag[4];
#pragma unroll
        for (int s = 0; s < 4; ++s) { float xg[8]; const f32x4 m0 = *(const LAS f32x4*)(MU3 + 32 * s + 8 * g), m1 = *(const LAS f32x4*)(MU3 + 32 * s + 8 * g + 4);
            xg[0] = bflo(xc[s].x) + (bflo(xp[s].x) - bflo(xc[s].x)) * m0.x; xg[1] = bfhi(xc[s].x) + (bfhi(xp[s].x) - bfhi(xc[s].x)) * m0.y;
            xg[2] = bflo(xc[s].y) + (bflo(xp[s].y) - bflo(xc[s].y)) * m0.z; xg[3] = bfhi(xc[s].y) + (bfhi(xp[s].y) - bfhi(xc[s].y)) * m0.w;
            xg[4] = bflo(xc[s].z) + (bflo(xp[s].z) - bflo(xc[s].z)) * m1.x; xg[5] = bfhi(xc[s].z) + (bfhi(xp[s].z) - bfhi(xc[s].z)) * m1.y;
            xg[6] = bflo(xc[s].w) + (bflo(xp[s].w) - bflo(xc[s].w)) * m1.z; xg[7] = bfhi(xc[s].w) + (bfhi(xp[s].w) - bfhi(xc[s].w)) * m1.w;
#pragma unroll
            for (int i = 0; i < 8; ++i) xg[i] = sigm(xg[i]);
            ag[s] = pack8(xg); }
        f32x4 y[4], gt[4];
#pragma unroll
        for (int ct = 0; ct < 4; ++ct) {
            bf16x8 gb[4];
#pragma unroll
            for (int s = 0; s < 4; ++s) gb[s] = *(const LAS bf16x8*)(GT + (16 * ct + q) * R3_GP + (32 * s + 8 * g) * 2);
            f32x4 acc = __builtin_amdgcn_mfma_f32_16x16x32_bf16(a0, zb[ct][0], yl[ct], 0, 0, 0);
            y[ct] = __builtin_amdgcn_mfma_f32_16x16x32_bf16(a1, zb[ct][1], acc, 0, 0, 0);
            f32x4 ga = zero4();
#pragma unroll
            for (int s = 0; s < 4; ++s) ga = __builtin_amdgcn_mfma_f32_16x16x32_bf16(ag[s], gb[s], ga, 0, 0, 0);
            gt[ct] = ga; }
#pragma unroll
        for (int r = 0; r < 4; ++r) {
            float s = (y[0][r] + y[1][r]) + (y[2][r] + y[3][r]);
            s = sum16(s);
            const float mean = s * (1.0f / 64.0f);
            float v = 0.f;
#pragma unroll
            for (int ct = 0; ct < 4; ++ct) { const float dd = y[ct][r] - mean; y[ct][r] = dd; v += dd * dd; }
            v = sum16(v);
            const float rs = __builtin_amdgcn_rsqf(v * (1.0f / 64.0f) + 64e-5f);
#pragma unroll
            for (int ct = 0; ct < 4; ++ct) y[ct][r] *= rs; }
#pragma unroll
        for (int ct = 0; ct < 4; ++ct) { const int cg = h * 64 + 16 * ct + q; const float lg = LG[16 * ct + q], lb = LB[16 * ct + q];
            const f32x4 bv = bvv[ct];
#pragma unroll
            for (int r = 0; r < 4; ++r) { const float o = (y[ct][r] * lg + lb + bv[r]) * gt[ct][r];
                F.Y[(tok0 + 4 * g + r) * D + cg] = (bf16)f2bf(o); } }
    }
    __syncthreads();
}

constexpr size_t RTS_QG = 0, RTS_KG = 16 * MiB, RTS_VTG = 32 * MiB, RTS_HLOC = 48 * MiB, RTS_Z0T = 80 * MiB, RTS_BYTES = 96 * MiB;
__device__ __forceinline__ float ret_loggamma(int h) { return __logf(1.0f - exp2f(-5.0f - (float)h)); }
__device__ __forceinline__ void ph_ret_c1(Frame& F, unsigned char* RTS) {
    LAS unsigned char* L = F.lds;
    bf16* QG = (bf16*)(RTS + RTS_QG); bf16* KG = (bf16*)(RTS + RTS_KG); bf16* VTG = (bf16*)(RTS + RTS_VTG); float* HLOC = (float*)(RTS + RTS_HLOC);
    const int lane = F.lane, w = F.wave, q = lane & 15, g = lane >> 4;
    unsigned praw[24]; float pcsn[16];
#define C1_ISSUE(chx) { const int bh_ = (chx) >> 6, chunk_ = (chx) & 63, b_ = bh_ >> 2, h_ = bh_ & 3; const size_t tk_ = (size_t)b_ * SEQ + chunk_ * 64; const int cg_ = h_ * 64 + lane, fi_ = lane & 31; \
        _Pragma("unroll") for (int j = 0; j < 8; ++j) { const int t = 8 * w + j, pos = chunk_ * 64 + t; const bf16* pp = F.P + pix(tk_ + t, C_RQ + cg_); \
            praw[3 * j] = pp[0]; praw[3 * j + 1] = pp[4 * PLANE]; praw[3 * j + 2] = pp[8 * PLANE]; \
            pcsn[2 * j] = F.TAB[TAB_COS + pos * 32 + fi_]; pcsn[2 * j + 1] = F.TAB[TAB_SIN + pos * 32 + fi_]; } }
    if (F.bid < NB * 4 * 64) C1_ISSUE(F.bid)
    for (int ch = F.bid; ch < NB * 4 * 64; ch += F.G) {
        const int bh = ch >> 6, chunk = ch & 63, b = bh >> 2, h = bh & 3;
        const size_t tok0 = (size_t)b * SEQ + chunk * 64;
        const float lgm = ret_loggamma(h);
        { const int c = lane, cg = h * 64 + c;
          float kg[8], vv[8];
          unsigned raw[24]; float csn[16];
#pragma unroll
          for (int k = 0; k < 24; ++k) { raw[k] = praw[k]; PIN(raw[k]); }
#pragma unroll
          for (int k = 0; k < 16; ++k) { csn[k] = pcsn[k]; PIN(csn[k]); }
          { const int chn = (ch + F.G < NB * 4 * 64) ? ch + F.G : ch; C1_ISSUE(chn) }
#pragma unroll
          for (int j = 0; j < 8; ++j) { const int t = 8 * w + j;
              const float qc = bflo(raw[3 * j]), kc = bflo(raw[3 * j + 1]); vv[j] = bflo(raw[3 * j + 2]);
              const float cs = csn[2 * j], sn = csn[2 * j + 1];
              const float qo = xor32(qc, c), ko = xor32(kc, c);
              const float qr = (c < 32) ? (qc * cs - qo * sn) : (qo * sn + qc * cs);
              const float kr = (c < 32) ? (kc * cs - ko * sn) : (ko * sn + kc * cs);
              const float qgv = qr * __expf(lgm * (float)t); kg[j] = kr * 0.125f * __expf(-lgm * (float)t);
              QG[(tok0 + t) * 256 + cg] = (bf16)f2bf(qgv); KG[(tok0 + t) * 256 + cg] = (bf16)f2bf(kg[j]); }
          const bf16x8 kp = pack8(kg), vp = pack8(vv);
          *(LAS bf16x8*)(L + 0 * RWU + c * RWP + 16 * w) = kp; *(LAS bf16x8*)(L + 1 * RWU + c * RWP + 16 * w) = vp;
          *(GAS bf16x8*)(VTG + ((size_t)ch * 64 + c) * 64 + 8 * w) = vp; }
        __syncthreads();
        const float g63 = __expf(lgm * 63.0f);
#pragma unroll
        for (int k = 0; k < 2; ++k) { const int ti = 2 * w + k, ra0 = 16 * (ti >> 2), rb0 = 16 * (ti & 3);
            f32x4 d = gram_tile(L + 0 * RWU, ra0, L + 1 * RWU, rb0, q, g, zero4());
            *(GAS f32x4*)(HLOC + (((size_t)ch * 16 + ti) * 64 + lane) * 4) = d * g63; }
        __syncthreads();
    }
#undef C1_ISSUE
}
__device__ __forceinline__ void ph_ret_c2(Frame& F, unsigned char* RTS, int blk0) {
    const float* HLOC = (const float*)(RTS + RTS_HLOC); bf16* Z0T = (bf16*)(RTS + RTS_Z0T);
    const int lane = F.lane, q = lane & 15, g = lane >> 4;
    for (int task = (F.bid - blk0) * NWAVES + F.wave; task >= 0 && task < 32 * 16; task += F.G * NWAVES) {
        const int bh = task >> 4, ti = task & 15, td = ti >> 2, te = ti & 3, h = bh & 3;
        const float g64 = __expf(ret_loggamma(h) * 64.0f);
        f32x4 z = zero4();
        const float* hb = HLOC + ((((size_t)bh * 64) * 16 + ti) * 64 + lane) * 4;
        f32x4 hn[16];
#pragma unroll
        for (int k = 0; k < 16; ++k) hn[k] = *(const GAS f32x4*)(hb + (size_t)k * 4096);
        for (int c16 = 0; c16 < 64; c16 += 16) {
            f32x4 hc[16];
#pragma unroll
            for (int k = 0; k < 16; ++k) hc[k] = hn[k];
            if (c16 + 16 < 64) {
#pragma unroll
                for (int k = 0; k < 16; ++k) hn[k] = *(const GAS f32x4*)(hb + (size_t)(c16 + 16 + k) * 4096); }
#pragma unroll
            for (int k = 0; k < 16; ++k) { const size_t ch = (size_t)bh * 64 + c16 + k;
                v2u o; o.x = pk2(z[0], z[1]); o.y = pk2(z[2], z[3]);
                *(GAS v2u*)(Z0T + (ch * 64 + 16 * te + q) * 64 + 16 * td + 4 * g) = o;
                z = z * g64 + hc[k]; }
        }
    }
}
__device__ __forceinline__ void ph_ret_c3(Frame& F, int l, unsigned char* RTS) {
    const bf16* QG = (const bf16*)(RTS + RTS_QG); const bf16* KG = (const bf16*)(RTS + RTS_KG); const bf16* VTG = (const bf16*)(RTS + RTS_VTG); const bf16* Z0T = (const bf16*)(RTS + RTS_Z0T);
    const int lane = F.lane, q = lane & 15, g = lane >> 4;
    LAS unsigned char* Sc = F.lds + F.wave * 2304;
    int hcur = -1; float hgg[4] = {0.f, 0.f, 0.f, 0.f}, hgb[4] = {0.f, 0.f, 0.f, 0.f};
    for (int task = F.bid * NWAVES + F.wave; task < NB * 4 * 64 * 4; task += F.G * NWAVES) {
        const int ch = task >> 2, rt = task & 3, bh = ch >> 6, chunk = ch & 63, b = bh >> 2, h = bh & 3;
        if (h != hcur) { hcur = h;
#pragma unroll
            for (int ct = 0; ct < 4; ++ct) { hgg[ct] = F.gn_g[l * 256 + h * 64 + 16 * ct + q]; hgb[ct] = F.gn_b[l * 256 + h * 64 + 16 * ct + q]; } }
        const size_t tokc = (size_t)b * SEQ + chunk * 64;
        const float gam = 1.0f - exp2f(-5.0f - (float)h);
        const bf16* qp = QG + (tokc + 16 * rt + q) * 256 + h * 64 + 8 * g;
        bf16x8 q0 = *(const GAS bf16x8*)qp, q1 = *(const GAS bf16x8*)(qp + 32);
        bf16x8 kf[4][2];
#pragma unroll
        for (int st = 0; st < 4; ++st) { const bf16* kp = KG + (tokc + 16 * st + q) * 256 + h * 64 + 8 * g; kf[st][0] = *(const GAS bf16x8*)kp; kf[st][1] = *(const GAS bf16x8*)(kp + 32); }
        unsigned graw[16];
#pragma unroll
        for (int ct = 0; ct < 4; ++ct)
#pragma unroll
            for (int r = 0; r < 4; ++r) graw[ct * 4 + r] = F.P[pix(tokc + 16 * rt + 4 * g + r, C_RG + h * 64 + 16 * ct + q)];
        bf16x8 zf[4][2], vf[4][2];
#pragma unroll
        for (int ct = 0; ct < 4; ++ct) { const bf16* zp = Z0T + ((size_t)ch * 64 + 16 * ct + q) * 64 + 8 * g; zf[ct][0] = *(const GAS bf16x8*)zp; zf[ct][1] = *(const GAS bf16x8*)(zp + 32);
            const bf16* vp = VTG + ((size_t)ch * 64 + 16 * ct + q) * 64 + 8 * g; vf[ct][0] = *(const GAS bf16x8*)vp; vf[ct][1] = *(const GAS bf16x8*)(vp + 32); }
        PIN(q0); PIN(q1);
#pragma unroll
        for (int st = 0; st < 4; ++st) { PIN(kf[st][0]); PIN(kf[st][1]); }
#pragma unroll
        for (int st = 0; st < 4; ++st) {
            f32x4 d = zero4();
            d = __builtin_amdgcn_mfma_f32_16x16x32_bf16(kf[st][0], q0, d, 0, 0, 0); d = __builtin_amdgcn_mfma_f32_16x16x32_bf16(kf[st][1], q1, d, 0, 0, 0);
#pragma unroll
            for (int r = 0; r < 4; ++r) if (!(16 * st + 4 * g + r <= 16 * rt + q)) d[r] = 0.f;
            v2u o; o.x = pk2h(d[0], d[1]); o.y = pk2h(d[2], d[3]);
            *(LAS v2u*)(Sc + q * RWP + (16 * st + 4 * g) * 2) = o; }
        asm volatile("s_waitcnt lgkmcnt(0)" ::: "memory");
        const bf16x8 s0 = *(const LAS bf16x8*)(Sc + q * RWP + 16 * g), s1 = *(const LAS bf16x8*)(Sc + q * RWP + 64 + 16 * g);
        asm volatile("" ::: "memory");
#pragma unroll
        for (int ct = 0; ct < 4; ++ct) { PIN(zf[ct][0]); PIN(zf[ct][1]); PIN(vf[ct][0]); PIN(vf[ct][1]); }
#pragma unroll
        for (int k = 0; k < 16; ++k) PIN(graw[k]);
        f32x4 y[4];
#pragma unroll
        for (int ct = 0; ct < 4; ++ct) {
            f32x4 acc = zero4();
            acc = __builtin_amdgcn_mfma_f32_16x16x32_bf16(q0, zf[ct][0], acc, 0, 0, 0);
            acc = __builtin_amdgcn_mfma_f32_16x16x32_bf16(q1, zf[ct][1], acc, 0, 0, 0);
            acc = acc * gam;
            acc = __builtin_amdgcn_mfma_f32_16x16x32_bf16(s0, vf[ct][0], acc, 0, 0, 0);
            acc = __builtin_amdgcn_mfma_f32_16x16x32_bf16(s1, vf[ct][1], acc, 0, 0, 0);
            y[ct] = acc; }
#pragma unroll
        for (int r = 0; r < 4; ++r) {
            float s = (y[0][r] + y[1][r]) + (y[2][r] + y[3][r]);
            s = sum16(s);
            const float mean = s * (1.0f / 64.0f);
            float v = 0.f;
#pragma unroll
            for (int ct = 0; ct < 4; ++ct) { const float dd = y[ct][r] - mean; y[ct][r] = dd; v += dd * dd; }
            v = sum16(v);
            const float rs = __builtin_amdgcn_rsqf(v * (1.0f / 64.0f) + LN_EPS);
#pragma unroll
            for (int ct = 0; ct < 4; ++ct) y[ct][r] *= rs; }
#pragma unroll
        for (int ct = 0; ct < 4; ++ct) { const int cg = h * 64 + 16 * ct + q; const float gg = hgg[ct], gb = hgb[ct];
#pragma unroll
            for (int r = 0; r < 4; ++r) { const size_t tok = tokc + 16 * rt + 4 * g + r; const float ge = bflo(graw[ct * 4 + r]);
                F.Y[tok * D + 768 + cg] = (bf16)f2bf(ge * sigm(ge) * (y[ct][r] * gg + gb)); } }
    }
}

#ifndef REP_MIX
#define REP_MIX 1
#endif
#ifndef REP_GEMM
#define REP_GEMM 1
#endif
#ifndef REP_LNX
#define REP_LNX 1
#endif
#ifndef WGM_WIDE
#define WGM_WIDE 4
#endif
#ifndef WGM_MGU
#define WGM_MGU 4
#endif
#ifndef WGM_N1K
#define WGM_N1K 4
#endif
#ifndef REP_MDN
#define REP_MDN 1
#endif
#ifndef REP_MGU
#define REP_MGU 1
#endif
#ifndef REP_INP
#define REP_INP 1
#endif
#ifndef REP_OUTP
#define REP_OUTP 1
#endif
#ifndef REP_BAR
#define REP_BAR 1
#endif
#ifndef REP_PRO
#define REP_PRO 1
#endif
#ifndef REP_GATH
#define REP_GATH 1
#endif
#ifndef REP_R1
#define REP_R1 1
#endif
#ifndef REP_C1
#define REP_C1 1
#endif
#ifndef REP_ATT
#define REP_ATT 1
#endif
#ifndef ATT_PROBE_MODE
#define ATT_PROBE_MODE 0
#endif
#ifndef REP_S2
#define REP_S2 1
#endif
#ifndef REP_R3
#define REP_R3 1
#endif
#ifndef REP_C3
#define REP_C3 1
#endif
struct Args { const float* in[26]; float* out; unsigned char* ws; int ph_lo, ph_hi; };
constexpr int N_PHASES = 1 + 2 * 9 + 2 * 10;

typedef const __attribute__((address_space(4))) Args* KArgs;
__device__ __forceinline__ void mk_frame(Frame& F, LAS unsigned char* lds) {
    KArgs ka = (KArgs)__builtin_amdgcn_kernarg_segment_ptr(); asm volatile("" : "+s"(ka));
    F.lds = lds; F.MISC = (volatile LAS unsigned*)(lds + MISC_OFF);
    { int t_ = threadIdx.x; asm volatile("" : "+v"(t_)); F.tid = t_; }
    { int b_ = blockIdx.x; asm volatile("" : "+s"(b_)); F.bid = b_; }
    F.lane = F.tid & 63; F.wave = __builtin_amdgcn_readfirstlane(F.tid >> 6); F.G = gridDim.x;
    F.lo = ka->ph_lo; F.hi = ka->ph_hi;
    unsigned char* ws = ka->ws; F.wsb = ws;
    F.ctl = (gu32*)(ws + WS_CTL);
    F.x = ka->in[0]; F.w_in = ka->in[1]; F.w_out = ka->in[2]; F.mu = ka->in[3]; F.w0 = ka->in[4]; F.w_up = ka->in[5]; F.a0 = ka->in[6]; F.a_up = ka->in[7]; F.g_up = ka->in[8];
    F.k_k = ka->in[9]; F.k_a = ka->in[10]; F.r_k = ka->in[11]; F.rln_g = ka->in[12]; F.rln_b = ka->in[13]; F.gn_g = ka->in[14]; F.gn_b = ka->in[15]; F.rel_bias = ka->in[16];
    F.ln_g = ka->in[17]; F.ln_b = ka->in[18]; F.ffn_g = ka->in[19]; F.ffn_u = ka->in[20]; F.ffn_d = ka->in[21]; F.router = ka->in[22]; F.moe_g = ka->in[23]; F.moe_u = ka->in[24]; F.moe_d = ka->in[25];
    F.out = ka->out;
    F.TAB = (float*)(ws + WS_TAB);
    F.WIN_T = (bf16*)(ws + WS_WIN); F.WOUT_T = (bf16*)(ws + WS_WOUT); F.WGU_T = (bf16*)(ws + WS_WGU); F.WD_T = (bf16*)(ws + WS_WD); F.WGUE = (bf16*)(ws + WS_WGUE); F.WDE = (bf16*)(ws + WS_WDE);
    F.XB = (bf16*)(ws + WS_XB); F.P = (bf16*)(ws + WS_SH + SH_P); F.Y = (bf16*)(ws + WS_SH + SH_Y);
    F.HB = (bf16*)(ws + WS_SH + SH_H); F.HID = (bf16*)(ws + WS_SH + SH_HID); F.HIDM = (bf16*)(ws + WS_SH + SH_HIDM); F.XG = (bf16*)(ws + WS_SH + SH_XG); F.TOK = ws + WS_SH + SH_TOK;
}

__global__ void __launch_bounds__(NTHR, 2) fwd_kernel(Args args) {
    extern __shared__ __attribute__((aligned(16))) unsigned char lds[];
    const int tid0 = threadIdx.x;
    for (int u = tid0; u < (LDS_BYTES - LDSCTL_OFF) / 4; u += NTHR) ((LAS unsigned*)((LAS unsigned char*)lds + LDSCTL_OFF))[u] = 0u;
    __syncthreads();
    if (args.ph_hi - args.ph_lo > 1) (void)xcd_barrier_post((unsigned*)(args.ws + WS_CTL) + CW_BAR, (volatile LAS unsigned*)((LAS unsigned char*)lds + MISC_OFF) + 8);
#define PH_BEGIN_R(phx, reps) { KArgs ka_ = (KArgs)__builtin_amdgcn_kernarg_segment_ptr(); asm volatile("" : "+s"(ka_)); const int lo_ = ka_->ph_lo, hi_ = ka_->ph_hi, ph = (phx); if (ph >= lo_ && ph < hi_) { \
    _Pragma("unroll 1") for (int rep_ = 0; rep_ < (reps); ++rep_) { Frame F; mk_frame(F, (LAS unsigned char*)lds);
#define PH_BEGIN(phx) PH_BEGIN_R(phx, 1)
#define PH_BEGIN_G(phx) PH_BEGIN_R(phx, REP_GEMM)
#define PH_BEGIN_M(phx) PH_BEGIN_R(phx, REP_MIX)
#define PH_END   } if (ph + 1 < hi_) { KArgs kb_ = (KArgs)__builtin_amdgcn_kernarg_segment_ptr(); asm volatile("" : "+s"(kb_)); XcdBarrier b_; b_.bar = (unsigned*)(kb_->ws + WS_CTL) + CW_BAR; b_.x = xb_xcc_id(); \
        b_.st = (volatile LAS unsigned*)((LAS unsigned char*)lds + MISC_OFF) + 8; _Pragma("unroll 1") for (int rb_ = 0; rb_ < REP_BAR; ++rb_) xcd_barrier(b_); } } }

    PH_BEGIN_R(0, REP_PRO) ph_prologue(F); PH_END

    for (int l = 0; l < DEPTH; ++l) {
        const int jj = l >> 1; const bool moe = (l & 1) != 0; const int pb = 1 + jj * 19 + (l & 1) * 9;
        PH_BEGIN_R(pb + 0, REP_GEMM * REP_INP)
            pg8::Gemm g{F.XB, F.WIN_T + (size_t)l * NIN * D, T, NIN, D}; pg8::StaticOrder S; S.init(T, NIN, F.G, F.bid, WGM_WIDE);
            pg8::EpiPlane E{F.P};
            pg8::gemm_phase<pg8::EpiPlane, pg8::StaticOrder, true, true>(F.lds + RING_OFF, g, S, E);
        PH_END
        PH_BEGIN_M(pb + 1)
            if (l == 3) { convert_moe(F, 1); __syncthreads(); }
_Pragma("unroll 1") for (int r_ = 0; r_ < REP_R1; ++r_) { Frame F2; mk_frame(F2, (LAS unsigned char*)lds); ph_rwkv_r1(F2, l, F2.wsb + WS_SH + SH_RWS); }
_Pragma("unroll 1") for (int r_ = 0; r_ < REP_C1; ++r_) { Frame F2; mk_frame(F2, (LAS unsigned char*)lds); ph_ret_c1(F2, F2.wsb + WS_SH + SH_RTS); }
_Pragma("unroll 1") for (int r_ = 0; r_ < REP_ATT; ++r_) { Frame F2; mk_frame(F2, (LAS unsigned char*)lds); ph_attn_mfma(F2, (bf16*)(F2.wsb + WS_SH + SH_OP), (float*)(F2.wsb + WS_SH + SH_LSE)); }
        PH_END
        PH_BEGIN_M(pb + 2)
_Pragma("unroll 1") for (int r_ = 0; r_ < REP_S2; ++r_) { Frame F2; mk_frame(F2, (LAS unsigned char*)lds);
            ph_rwkv_r2(F2, F2.wsb + WS_SH + SH_RWS);
            ph_ret_c2(F2, F2.wsb + WS_SH + SH_RTS, 128);
            ph_attn_merge(F2, (const bf16*)(F2.wsb + WS_SH + SH_OP), (const float*)(F2.wsb + WS_SH + SH_LSE)); }
        PH_END
        PH_BEGIN_M(pb + 3)
_Pragma("unroll 1") for (int r_ = 0; r_ < REP_R3; ++r_) { Frame F2; mk_frame(F2, (LAS unsigned char*)lds); ph_rwkv_r3(F2, l, F2.wsb + WS_SH + SH_RWS); }
_Pragma("unroll 1") for (int r_ = 0; r_ < REP_C3; ++r_) { Frame F2; mk_frame(F2, (LAS unsigned char*)lds); ph_ret_c3(F2, l, F2.wsb + WS_SH + SH_RTS); }
        PH_END
        PH_BEGIN_R(pb + 4, REP_GEMM * REP_OUTP)
            pg8::Gemm g{F.Y, F.WOUT_T + (size_t)l * D * D, T, D, D}; pg8::StaticOrder S; S.init(T, D, F.G, F.bid, WGM_N1K);
            pg8::EpiBf16<0> E{F.HB, D, nullptr, 0, 0, 1.f};
            pg8::gemm_phase<pg8::EpiBf16<0>, pg8::StaticOrder, true, true>(F.lds + RING_OFF, g, S, E);
        PH_END
        PH_BEGIN_R(pb + 5, REP_LNX)
            if (moe) ph_ln<1, false>(F, nullptr, nullptr, F.ln_g + (size_t)(l * 2) * D, F.ln_b + (size_t)(l * 2) * D, F.router + (size_t)jj * D * NE, rep_ ? (bf16*)(F.wsb + WS_SH + SH_OP) : F.XB, rep_ > 0);
            else if (l == 0) ph_ln<0, true>(F, F.x, nullptr, F.ln_g + (size_t)(l * 2) * D, F.ln_b + (size_t)(l * 2) * D, nullptr, rep_ ? (bf16*)(F.wsb + WS_SH + SH_OP) : F.XB, rep_ > 0, 0x7fffffff, nullptr, 0, DENSE_F8 ? (unsigned char*)F.XG : nullptr);
            else ph_ln<0, false>(F, nullptr, nullptr, F.ln_g + (size_t)(l * 2) * D, F.ln_b + (size_t)(l * 2) * D, nullptr, rep_ ? (bf16*)(F.wsb + WS_SH + SH_OP) : F.XB, rep_ > 0, 0x7fffffff, nullptr, 0, DENSE_F8 ? (unsigned char*)F.XG : nullptr);
        PH_END
        if (!moe) {
            PH_BEGIN_G(pb + 6)
                pg8::Gemm g{DENSE_F8 ? F.XG : F.XB, DENSE_F8 ? (bf16*)((unsigned char*)F.WGU_T + (size_t)jj * 2 * FFD * D) : F.WGU_T + (size_t)jj * 2 * FFD * D, T, 2 * FFD, DENSE_F8 ? D / 2 : D}; pg8::StaticOrder S; S.init(T, 2 * FFD, F.G, F.bid, WGM_WIDE);
                pg8::EpiSwigluT<DENSE_DN_F8 != 0> E{F.HID, FFD, DENSE_F8 ? 1.0f / (F8_WS * F8_XS) : 1.0f, F8_HS};
                pg8::gemm_phase<pg8::EpiSwigluT<DENSE_DN_F8 != 0>, pg8::StaticOrder, true, true, DENSE_F8 != 0>(F.lds + RING_OFF, g, S, E);
            PH_END
            PH_BEGIN_G(pb + 7)
                pg8::Gemm g{F.HID, DENSE_DN_F8 ? (bf16*)((unsigned char*)F.WD_T + (size_t)jj * D * FFD) : F.WD_T + (size_t)jj * D * FFD, T, D, DENSE_DN_F8 ? FFD / 2 : FFD}; pg8::StaticOrder S; S.init(T, D, F.G, F.bid, WGM_N1K);
                pg8::EpiBf16<0> E{F.HB, D, nullptr, 0, 0, DENSE_DN_F8 ? 1.0f / (F8_HS * F8_WDS) : 1.f};
                pg8::gemm_phase<pg8::EpiBf16<0>, pg8::StaticOrder, true, true, DENSE_DN_F8 != 0>(F.lds + RING_OFF, g, S, E);
            PH_END
            PH_BEGIN_R(pb + 8, REP_LNX) ph_ln<0, false>(F, nullptr, nullptr, F.ln_g + (size_t)(l * 2 + 1) * D, F.ln_b + (size_t)(l * 2 + 1) * D, nullptr, rep_ ? (bf16*)(F.wsb + WS_SH + SH_OP) : F.XB, rep_ > 0); PH_END
        } else {
            PH_BEGIN_R(pb + 6, REP_GATH) ph_moe_gather(F); PH_END
            PH_BEGIN_R(pb + 7, REP_GEMM * REP_MGU)
                const GAS int* meta = (const GAS int*)(F.TAB + TAB_META);
                pg8::MoeOrder S;
#pragma unroll
                for (int e = 0; e < 8; ++e) S.pend[e] = __builtin_amdgcn_readfirstlane(meta[e]);
                const int nblk = S.pend[7] / 256;
                S.pm_off = 0; S.estride = (size_t)2 * FFE * D * (MOE_GU_F8 ? 1 : 2); S.init(nblk * 256, 2 * FFE, F.G, F.bid, WGM_MGU);
                pg8::Gemm g{F.XG, F.WGUE, nblk * 256, 2 * FFE, MOE_GU_F8 ? D / 2 : D};
                pg8::EpiSwigluT<MOE_DN_F8 != 0> E{F.HIDM, FFE, MOE_GU_F8 ? 1.0f / (F8_WS * F8_XS) : 1.0f, F8_HS};
                pg8::gemm_phase<pg8::EpiSwigluT<MOE_DN_F8 != 0>, pg8::MoeOrder, true, true, MOE_GU_F8 != 0>(F.lds + RING_OFF, g, S, E);
            PH_END
            PH_BEGIN_R(pb + 8, REP_GEMM * REP_MDN)
                const GAS int* meta = (const GAS int*)(F.TAB + TAB_META);
                pg8::MoeOrder S;
#pragma unroll
                for (int e = 0; e < 8; ++e) S.pend[e] = __builtin_amdgcn_readfirstlane(meta[e]);
                const int nblk = S.pend[7] / 256, nlo = nblk & 63, nmain = nblk - nlo;
                S.pm_off = 0; S.estride = (size_t)D * FFE * (MOE_DN_F8 ? 1 : 2); S.init(nmain * 256, D, F.G, F.bid, WGM_N1K);
                pg8::Gemm g{F.HIDM, F.WDE, nmain * 256, D, MOE_DN_F8 ? FFE / 2 : FFE};
                pg8::EpiBf16<0> E{F.XG, D, nullptr, 0, 0, MOE_DN_F8 ? 1.0f / (F8_HS * F8_WDS) : 1.f};
                pg8::gemm_phase<pg8::EpiBf16<0>, pg8::MoeOrder, true, true, MOE_DN_F8 != 0>(F.lds + RING_OFF, g, S, E);
                if (nlo > 0) {
                    pg8::MoeSubOrder S2; S2.nsub = nlo * 4 * 7; S2.G = F.G; S2.c = F.bid; S2.pm_lo = nmain; S2.estride = (size_t)D * FFE * (MOE_DN_F8 ? 1 : 2); S2.kbytes = MOE_DN_F8 ? 512 : 1024;
#pragma unroll
                    for (int e = 0; e < 8; ++e) S2.pend[e] = S.pend[e];
                    pg8::Gemm g2{F.HIDM, F.WDE, nblk * 256, D, MOE_DN_F8 ? 256 : 512, MOE_DN_F8 ? FFE / 2 : FFE};
                    pg8::EpiSlab E2{(bf16*)(F.wsb + WS_SH + SH_SLAB), nmain, (size_t)nlo * 256 * D, MOE_DN_F8 ? 1.0f / (F8_HS * F8_WDS) : 1.f};
                    pg8::gemm_phase<pg8::EpiSlab, pg8::MoeSubOrder, true, true, MOE_DN_F8 != 0>(F.lds + RING_OFF, g2, S2, E2);
                }
            PH_END
            PH_BEGIN_R(pb + 9, REP_LNX)
                const int nblk_ = __builtin_amdgcn_readfirstlane(((const GAS int*)(F.TAB + TAB_META))[7]) / 256, nlo_ = nblk_ & 63;
                ph_ln<2, false>(F, nullptr, (l == DEPTH - 1) ? F.out : nullptr, F.ln_g + (size_t)(l * 2 + 1) * D, F.ln_b + (size_t)(l * 2 + 1) * D, nullptr, rep_ ? (bf16*)(F.wsb + WS_SH + SH_OP) : F.XB, rep_ > 0,
                                (nblk_ - nlo_) * 256, (const bf16*)(F.wsb + WS_SH + SH_SLAB), (size_t)nlo_ * 256 * D);
            PH_END
        }
    }
#undef PH_BEGIN
#undef PH_END
}

#ifndef MK_ONE_LAUNCH
#define MK_ONE_LAUNCH 1
#endif
extern "C" void kernel_launch(void* const* d_in, const int* in_sizes, int n_in, void* d_out, int out_size, void* d_ws, size_t ws_size, hipStream_t stream) {
    static int grid = 0;
    if (grid == 0) {
        if (n_in != 26 || in_sizes[0] != T * D || out_size != T * D || ws_size < WS_END) { fprintf(stderr, "kernel_launch: unexpected shapes (n_in %d, in0 %d, out %d, ws %zu); nothing launched\n", n_in, n_in > 0 ? in_sizes[0] : -1, out_size, ws_size); grid = -1; return; }
        int dev = 0, cus = 0, per_cu = 0;
        if (hipGetDevice(&dev) != hipSuccess || hipDeviceGetAttribute(&cus, hipDeviceAttributeMultiprocessorCount, dev) != hipSuccess) { grid = -1; return; }
        if (hipFuncSetAttribute((const void*)fwd_kernel, hipFuncAttributeMaxDynamicSharedMemorySize, LDS_BYTES) != hipSuccess) { fprintf(stderr, "kernel_launch: hipFuncSetAttribute failed\n"); grid = -1; return; }
        if (hipOccupancyMaxActiveBlocksPerMultiprocessor(&per_cu, (const void*)fwd_kernel, NTHR, LDS_BYTES) != hipSuccess || per_cu < 1) fprintf(stderr, "kernel_launch: occupancy query reports %d\n", per_cu);
        (void)hipGetLastError();
        grid = cus;
    }
    if (grid < 0) return;
    if (hipMemsetAsync((char*)d_ws + WS_CTL, 0, CTL_ZERO_BYTES, stream) != hipSuccess) return;
    Args a{};
    for (int i = 0; i < 26; ++i) a.in[i] = (const float*)d_in[i];
    a.out = (float*)d_out; a.ws = (unsigned char*)d_ws;
#if MK_ONE_LAUNCH
    a.ph_lo = 0; a.ph_hi = N_PHASES;
    hipLaunchKernelGGL(fwd_kernel, dim3(grid), dim3(NTHR), LDS_BYTES, stream, a);
#else
    for (int p = 0; p < N_PHASES; ++p) { a.ph_lo = p; a.ph_hi = p + 1; hipLaunchKernelGGL(fwd_kernel, dim3(grid), dim3(NTHR), LDS_BYTES, stream, a); }
#endif
}
```
